# Optimizing an MI355X kernel written in HIP

```python
import math
import jax, jax.numpy as jnp
from jax import lax
import numpy as np

D_MODEL = 2048
BATCH = 4
SEQ = 2048
DEPTH = 2
DEC_BATCH = 128
DEC_SEQ = 4
PAST_LEN = 16384
PAGE_SIZE = 128

D_MIX = D_MODEL
ML_HEADS = 4
ML_DIM = D_MIX // 16
ML_WIDTH = ML_HEADS * ML_DIM
ML_CHUNK = 64
RW_HEAD = 64
RW_WIDTH = D_MIX // 2
RW_HEADS = RW_WIDTH // RW_HEAD
RW_LORA_W = 64
RW_LORA_A = 64
RW_LORA_G = 128
SG_WIDTH = D_MIX - ML_WIDTH - RW_WIDTH
SG_CHUNK = 128
SG_GROUP = 128
SG_GROUPS = SG_WIDTH // SG_GROUP
ML_COLS = 4 * ML_WIDTH + 2 * ML_HEADS
RW_COLS = 3 * RW_WIDTH + RW_LORA_W + RW_LORA_A + RW_LORA_G
SG_COLS = 2 * SG_WIDTH
N_IN = ML_COLS + RW_COLS + SG_COLS
D_FF = 5632
CONV_W = 3
EPS = 1e-6
RW_GN_EPS = RW_HEAD * 1e-5

kernel_name = 'hybrid_mlstm_rwkv7_sgu_convffn_step'


def rmsnorm(x, g):
    xf = x.astype(jnp.float32)
    y = xf * lax.rsqrt(jnp.mean(xf * xf, axis=-1, keepdims=True) + EPS)
    return (y * g.astype(jnp.float32)).astype(x.dtype)


def _heads(z, n_heads):
    return z.reshape(z.shape[:-1] + (n_heads, z.shape[-1] // n_heads))


def mlstm_mixer(p, b_i, b_f, norm_g, C0, n0, m0):
    bsz, T, _ = p.shape
    pf = p.astype(jnp.float32)
    q, k, v, o = [_heads(pf[..., j * ML_WIDTH:(j + 1) * ML_WIDTH], ML_HEADS) for j in range(4)]
    k = k * ML_DIM ** -0.5
    ig = pf[..., 4 * ML_WIDTH:4 * ML_WIDTH + ML_HEADS] + b_i
    lf = jax.nn.log_sigmoid(pf[..., 4 * ML_WIDTH + ML_HEADS:ML_COLS] + b_f)
    L = math.gcd(T, ML_CHUNK)
    nc = T // L

    def to_chunks(a):
        a = a.reshape((bsz, nc, L) + a.shape[2:])
        return jnp.moveaxis(a, (1, 3), (0, 2))

    causal = jnp.tril(jnp.ones((L, L), dtype=bool))

    def step(carry, xs):
        C, n, m = carry
        qc, kc, vc, igc, lfc = xs
        b = jnp.cumsum(lfc, axis=-1)
        inter = b + m[..., None]
        dmat = jnp.where(causal, b[..., :, None] - b[..., None, :] + igc[..., None, :], -jnp.inf)
        m_row = jnp.maximum(inter, jnp.max(dmat, axis=-1))
        s_inter = jnp.exp(inter - m_row)
        att = jnp.einsum('bhld,bhsd->bhls', qc, kc) * jnp.exp(dmat - m_row[..., None])
        num = s_inter[..., None] * jnp.einsum('bhld,bhde->bhle', qc, C) + jnp.einsum('bhls,bhse->bhle', att, vc)
        den = s_inter * jnp.einsum('bhld,bhd->bhl', qc, n) + jnp.sum(att, axis=-1)
        h = num / jnp.maximum(jnp.abs(den), jnp.exp(-m_row))[..., None]
        b_last = b[..., -1]
        g = b_last[..., None] - b + igc
        m_new = jnp.maximum(b_last + m, jnp.max(g, axis=-1))
        wk = jnp.exp(g - m_new[..., None])
        dec = jnp.exp(b_last + m - m_new)
        C = dec[..., None, None] * C + jnp.einsum('bhl,bhld,bhle->bhde', wk, kc, vc)
        n = dec[..., None] * n + jnp.einsum('bhl,bhld->bhd', wk, kc)
        return (C, n, m_new), h

    carry0 = (C0.astype(jnp.float32), n0.astype(jnp.float32), m0.astype(jnp.float32))
    xs = tuple(to_chunks(a) for a in (q, k, v, ig, lf))
    (C, n, m), hs = lax.scan(step, carry0, xs)
    h = jnp.moveaxis(hs, (0, 2), (1, 3)).reshape(bsz, T, ML_HEADS, ML_DIM)
    h = h * lax.rsqrt(jnp.mean(h * h, axis=-1, keepdims=True) + EPS)
    out = h.reshape(bsz, T, ML_WIDTH) * norm_g * jax.nn.sigmoid(o.reshape(bsz, T, ML_WIDTH))
    return out, C, n, m


def rwkv7_mixer(p, shift0, S0, mu, w0, w_up, a0, a_up, g_up, k_k, k_a, r_k, ln_g, ln_b):
    bsz, T, _ = p.shape
    pf = p.astype(jnp.float32)
    prev = jnp.concatenate([shift0[:, None, :].astype(jnp.float32), pf[:, :-1]], axis=1)
    px = pf + (prev - pf) * mu
    o1, o2, o3 = RW_WIDTH, 2 * RW_WIDTH, 3 * RW_WIDTH
    o4 = o3 + RW_LORA_W
    o5 = o4 + RW_LORA_A
    r, k, v = px[..., :o1], px[..., o1:o2], px[..., o2:o3]
    w_log = -jax.nn.softplus(-(w0 + jnp.tanh(px[..., o3:o4]) @ w_up)) - 0.5
    decay = jnp.exp(-jnp.exp(w_log))
    a = jax.nn.sigmoid(a0 + px[..., o4:o5] @ a_up)
    g = jax.nn.sigmoid(px[..., o5:]) @ g_up
    kk = _heads(k * k_k, RW_HEADS)
    kk = kk * lax.rsqrt(jnp.maximum(jnp.sum(kk * kk, axis=-1, keepdims=True), 1e-24))
    k = k * (1.0 + (a - 1.0) * k_a)
    rh, wh, kh, vh, ah = (_heads(z, RW_HEADS) for z in (r, decay, k, v, a))
    a_vec = -kk
    b_vec = kk * ah

    def step(S, xs):
        rt, wt, kt, vt, at, bt = xs
        Sa = jnp.einsum('bhvk,bhk->bhv', S, at)
        S = S * wt[:, :, None, :] + Sa[..., None] * bt[:, :, None, :] + vt[..., None] * kt[:, :, None, :]
        return S, jnp.einsum('bhvk,bhk->bhv', S, rt)

    xs = tuple(jnp.moveaxis(z, 1, 0) for z in (rh, wh, kh, vh, a_vec, b_vec))
    S, ys = lax.scan(step, S0.astype(jnp.float32), xs)
    y = jnp.moveaxis(ys, 0, 1)
    mean = jnp.mean(y, axis=-1, keepdims=True)
    var = jnp.mean(jnp.square(y - mean), axis=-1, keepdims=True)
    y = ((y - mean) * lax.rsqrt(var + RW_GN_EPS)).reshape(bsz, T, RW_WIDTH) * ln_g + ln_b
    bonus = jnp.sum(rh * kh * r_k, axis=-1, keepdims=True) * vh
    out = (y + bonus.reshape(bsz, T, RW_WIDTH)) * g
    return out, S, pf[:, -1]


def sgu_mixer(p, ln_g, ln_b, w_s, b_s):
    bsz, T, _ = p.shape
    z = jax.nn.gelu(p.astype(jnp.float32), approximate=False)
    u, v = z[..., :SG_WIDTH], z[..., SG_WIDTH:]
    v = v.reshape(bsz, T, SG_GROUPS, SG_GROUP)
    mean = jnp.mean(v, axis=-1, keepdims=True)
    var = jnp.mean(jnp.square(v - mean), axis=-1, keepdims=True)
    v = (v - mean) * lax.rsqrt(var + EPS) * ln_g.reshape(SG_GROUPS, SG_GROUP) + ln_b.reshape(SG_GROUPS, SG_GROUP)
    L = min(T, SG_CHUNK)
    Tp = -(-T // L) * L
    vp = jnp.pad(v, ((0, 0), (0, Tp - T), (0, 0), (0, 0))).reshape(bsz, Tp // L, L, SG_GROUPS, SG_GROUP)
    W = jnp.tril(w_s[:, :L, :L])
    mixed = jnp.einsum('gts,bcsgd->bctgd', W, vp) + b_s[:, :L].T[None, None, :, :, None]
    mixed = mixed.reshape(bsz, Tp, SG_GROUPS, SG_GROUP)[:, :T].reshape(bsz, T, SG_WIDTH)
    return u * mixed, v.reshape(bsz, T, SG_WIDTH)


def conv_ffn(x, buf, w_up, conv_w, conv_b, w_down):
    T = x.shape[1]
    h = x @ w_up
    hp = jnp.concatenate([buf.astype(h.dtype), h], axis=1)
    hc = conv_b
    for j in range(CONV_W):
        hc = hc + conv_w[j] * hp[:, j:j + T]
    gate, val = hc[..., :D_FF], hc[..., D_FF:]
    y = (jax.nn.silu(gate) * val) @ w_down
    return y, hp[:, -(CONV_W - 1):]


def trunk(x, C0, n0, m0, S0, sh0, cb0, prm, return_v):
    Cs, ns, ms, Ss, shs, cbs, vs = [], [], [], [], [], [], []
    for l in range(DEPTH):
        h = rmsnorm(x, prm['mix_norm_g'][l])
        p = h @ prm['w_in'][l]
        ym, C, n, m = mlstm_mixer(p[..., :ML_COLS], prm['mlstm_b_i'][l], prm['mlstm_b_f'][l],
                                  prm['mlstm_norm_g'][l], C0[l], n0[l], m0[l])
        yr, S, sh = rwkv7_mixer(p[..., ML_COLS:ML_COLS + RW_COLS], sh0[l], S0[l],
                                prm['rwkv_mu'][l], prm['rwkv_w0'][l], prm['rwkv_w_up'][l],
                                prm['rwkv_a0'][l], prm['rwkv_a_up'][l], prm['rwkv_g_up'][l],
                                prm['rwkv_k_k'][l], prm['rwkv_k_a'][l], prm['rwkv_r_k'][l],
                                prm['rwkv_ln_g'][l], prm['rwkv_ln_b'][l])
        ys, vrows = sgu_mixer(p[..., ML_COLS + RW_COLS:], prm['sgu_ln_g'][l], prm['sgu_ln_b'][l],
                              prm['sgu_w'][l], prm['sgu_b'][l])
        mix = jnp.concatenate([ym, yr, ys], axis=-1).astype(x.dtype)
        x = x + mix @ prm['w_out'][l]
        f, cb = conv_ffn(rmsnorm(x, prm['ffn_norm_g'][l]), cb0[l], prm['ffn_w_up'][l],
                         prm['ffn_conv_w'][l], prm['ffn_conv_b'][l], prm['ffn_w_down'][l])
        x = x + f
        Cs.append(C); ns.append(n); ms.append(m); Ss.append(S); shs.append(sh); cbs.append(cb)
        if return_v:
            vs.append(vrows)
    y = rmsnorm(x, prm['final_norm_g'])
    st = [jnp.stack(a) for a in (Cs, ns, ms, Ss, shs, cbs)]
    if return_v:
        st.append(jnp.stack(vs))
    return y, st


def setup_inputs(seed: int = 0) -> dict:
    key = jax.random.key(seed)
    ks = iter(jax.random.split(key, 48))

    def nrm(shape, scale):
        return jax.random.normal(next(ks), shape, jnp.float32) * scale

    D = D_MODEL
    d = {}
    d['x_prompt'] = nrm((BATCH, SEQ, D), 1.0)
    d['x_sample'] = nrm((DEC_BATCH, DEC_SEQ, D), 1.0)
    d['state_mlstm_C'] = nrm((DEPTH, DEC_BATCH, ML_HEADS, ML_DIM, ML_DIM), 0.1)
    d['state_mlstm_n'] = jnp.abs(nrm((DEPTH, DEC_BATCH, ML_HEADS, ML_DIM), 0.5))
    d['state_mlstm_m'] = nrm((DEPTH, DEC_BATCH, ML_HEADS), 1.0)
    d['state_rwkv_S'] = nrm((DEPTH, DEC_BATCH, RW_HEADS, RW_HEAD, RW_HEAD), 0.1)
    d['state_rwkv_shift'] = nrm((DEPTH, DEC_BATCH, RW_COLS), 1.0)
    d['state_ffn_conv'] = nrm((DEPTH, DEC_BATCH, CONV_W - 1, 2 * D_FF), 1.0)
    d['mix_norm_g'] = 1.0 + nrm((DEPTH, D), 0.02)
    d['w_in'] = nrm((DEPTH, D, N_IN), D ** -0.5)
    d['mlstm_b_i'] = nrm((DEPTH, ML_HEADS), 0.1)
    d['mlstm_b_f'] = 3.0 + nrm((DEPTH, ML_HEADS), 0.5)
    d['mlstm_norm_g'] = 1.0 + nrm((DEPTH, ML_WIDTH), 0.02)
    d['rwkv_mu'] = jax.random.uniform(next(ks), (DEPTH, RW_COLS), jnp.float32)
    d['rwkv_w0'] = nrm((DEPTH, RW_WIDTH), 0.5)
    d['rwkv_w_up'] = nrm((DEPTH, RW_LORA_W, RW_WIDTH), RW_LORA_W ** -0.5)
    d['rwkv_a0'] = nrm((DEPTH, RW_WIDTH), 0.1)
    d['rwkv_a_up'] = nrm((DEPTH, RW_LORA_A, RW_WIDTH), RW_LORA_A ** -0.5)
    d['rwkv_g_up'] = nrm((DEPTH, RW_LORA_G, RW_WIDTH), RW_LORA_G ** -0.5)
    d['rwkv_k_k'] = 0.85 + nrm((DEPTH, RW_WIDTH), 0.02)
    d['rwkv_k_a'] = 1.0 + nrm((DEPTH, RW_WIDTH), 0.02)
    d['rwkv_r_k'] = nrm((DEPTH, RW_HEADS, RW_HEAD), 0.1)
    d['rwkv_ln_g'] = 1.0 + nrm((DEPTH, RW_WIDTH), 0.02)
    d['rwkv_ln_b'] = nrm((DEPTH, RW_WIDTH), 0.02)
    d['sgu_ln_g'] = 1.0 + nrm((DEPTH, SG_WIDTH), 0.02)
    d['sgu_ln_b'] = nrm((DEPTH, SG_WIDTH), 0.02)
    d['sgu_w'] = nrm((DEPTH, SG_GROUPS, SG_CHUNK, SG_CHUNK), SG_CHUNK ** -0.5)
    d['sgu_b'] = 1.0 + nrm((DEPTH, SG_GROUPS, SG_CHUNK), 0.02)
    d['w_out'] = nrm((DEPTH, D_MIX, D), D_MIX ** -0.5)
    d['ffn_norm_g'] = 1.0 + nrm((DEPTH, D), 0.02)
    d['ffn_w_up'] = nrm((DEPTH, D, 2 * D_FF), D ** -0.5)
    d['ffn_conv_w'] = nrm((DEPTH, CONV_W, 2 * D_FF), CONV_W ** -0.5)
    d['ffn_conv_b'] = nrm((DEPTH, 2 * D_FF), 0.02)
    d['ffn_w_down'] = nrm((DEPTH, D_FF, D), D_FF ** -0.5)
    d['final_norm_g'] = 1.0 + nrm((D,), 0.02)
    return d


def reference(x_prompt, x_sample, state_mlstm_C, state_mlstm_n, state_mlstm_m, state_rwkv_S,
              state_rwkv_shift, state_ffn_conv, mix_norm_g, w_in, mlstm_b_i, mlstm_b_f, mlstm_norm_g,
              rwkv_mu, rwkv_w0, rwkv_w_up, rwkv_a0, rwkv_a_up, rwkv_g_up, rwkv_k_k, rwkv_k_a, rwkv_r_k,
              rwkv_ln_g, rwkv_ln_b, sgu_ln_g, sgu_ln_b, sgu_w, sgu_b, w_out, ffn_norm_g, ffn_w_up,
              ffn_conv_w, ffn_conv_b, ffn_w_down, final_norm_g):
    prm = dict(mix_norm_g=mix_norm_g, w_in=w_in, mlstm_b_i=mlstm_b_i, mlstm_b_f=mlstm_b_f,
               mlstm_norm_g=mlstm_norm_g, rwkv_mu=rwkv_mu, rwkv_w0=rwkv_w0, rwkv_w_up=rwkv_w_up,
               rwkv_a0=rwkv_a0, rwkv_a_up=rwkv_a_up, rwkv_g_up=rwkv_g_up, rwkv_k_k=rwkv_k_k,
               rwkv_k_a=rwkv_k_a, rwkv_r_k=rwkv_r_k, rwkv_ln_g=rwkv_ln_g, rwkv_ln_b=rwkv_ln_b,
               sgu_ln_g=sgu_ln_g, sgu_ln_b=sgu_ln_b, sgu_w=sgu_w, sgu_b=sgu_b, w_out=w_out,
               ffn_norm_g=ffn_norm_g, ffn_w_up=ffn_w_up, ffn_conv_w=ffn_conv_w,
               ffn_conv_b=ffn_conv_b, ffn_w_down=ffn_w_down, final_norm_g=final_norm_g)
    bp = x_prompt.shape[0]
    y_prompt, st_p = trunk(
        x_prompt,
        jnp.zeros((DEPTH, bp, ML_HEADS, ML_DIM, ML_DIM), jnp.float32),
        jnp.zeros((DEPTH, bp, ML_HEADS, ML_DIM), jnp.float32),
        jnp.zeros((DEPTH, bp, ML_HEADS), jnp.float32),
        jnp.zeros((DEPTH, bp, RW_HEADS, RW_HEAD, RW_HEAD), jnp.float32),
        jnp.zeros((DEPTH, bp, RW_COLS), jnp.float32),
        jnp.zeros((DEPTH, bp, CONV_W - 1, 2 * D_FF), jnp.float32),
        prm, False)
    y_sample, st_s = trunk(x_sample, state_mlstm_C, state_mlstm_n, state_mlstm_m, state_rwkv_S,
                           state_rwkv_shift, state_ffn_conv, prm, True)
    C_p, n_p, m_p, S_p, sh_p, cb_p = st_p
    C_s, n_s, m_s, S_s, sh_s, cb_s, v_s = st_s
    return (y_prompt, y_sample, C_p, n_p, m_p, S_p, sh_p, cb_p, C_s, n_s, m_s, S_s, sh_s, cb_s, v_s)
```

```cpp
#include <hip/hip_runtime.h>
#include <hip/hip_cooperative_groups.h>
#include <cstdio>
#include <cstdint>
namespace cg = cooperative_groups;

#ifndef C2_MASK
#define C2_MASK 0xFF
#endif
#ifndef DUP_MASK
#define DUP_MASK 0
#endif
#ifndef MK_ONE_LAUNCH
#define MK_ONE_LAUNCH 1
#endif

#define LAS __attribute__((address_space(3)))
typedef unsigned short bf16_t;
typedef short bf16x8 __attribute__((ext_vector_type(8)));
typedef float f32x4 __attribute__((ext_vector_type(4)));
typedef float f32x2 __attribute__((ext_vector_type(2)));
typedef unsigned u32x4 __attribute__((ext_vector_type(4)));
typedef unsigned u32x2 __attribute__((ext_vector_type(2)));

constexpr int DM = 2048, NPR = 8192, NSM = 512, TT = 8704, SEQ = 2048, DEPTH = 2;
constexpr int NIN = 6408, LDP = 6656, DFF = 5632, DFF2 = 11264;
constexpr int ML_Q = 0, ML_K = 512, ML_V = 1024, ML_O = 1536, ML_IG = 2048, ML_FG = 2052;
constexpr int RW0 = 2056, RW_R = 2056, RW_K = 3080, RW_V = 4104, RW_LW = 5128, RW_LA = 5192, RW_LG = 5256, RWC = 3328;
constexpr int SG_U = 5384, SG_V = 5896;
constexpr float EPS = 1e-6f;

constexpr size_t O_YP = 0;
constexpr size_t O_YS = O_YP + (size_t)4 * 2048 * 2048;
constexpr size_t O_CP = O_YS + (size_t)128 * 4 * 2048;
constexpr size_t O_NP = O_CP + (size_t)2 * 4 * 4 * 128 * 128;
constexpr size_t O_MP = O_NP + (size_t)2 * 4 * 4 * 128;
constexpr size_t O_SP = O_MP + (size_t)2 * 4 * 4;
constexpr size_t O_SHP = O_SP + (size_t)2 * 4 * 16 * 64 * 64;
constexpr size_t O_CBP = O_SHP + (size_t)2 * 4 * 3328;
constexpr size_t O_CS = O_CBP + (size_t)2 * 4 * 2 * 11264;
constexpr size_t O_NS = O_CS + (size_t)2 * 128 * 4 * 128 * 128;
constexpr size_t O_MS = O_NS + (size_t)2 * 128 * 4 * 128;
constexpr size_t O_SS = O_MS + (size_t)2 * 128 * 4;
constexpr size_t O_SHS = O_SS + (size_t)2 * 128 * 16 * 64 * 64;
constexpr size_t O_CBS = O_SHS + (size_t)2 * 128 * 3328;
constexpr size_t O_VS = O_CBS + (size_t)2 * 128 * 2 * 11264;
constexpr size_t O_END = O_VS + (size_t)2 * 128 * 4 * 512;

constexpr size_t MiB = 1u << 20;
constexpr size_t WS_CTL = 0, CTL_BYTES = 1 * MiB;
constexpr size_t WS_WIN = 1 * MiB;
constexpr size_t WS_WOUT = WS_WIN + 52 * MiB;
constexpr size_t WS_WUP = WS_WOUT + 16 * MiB;
constexpr size_t WS_WDN = WS_WUP + 88 * MiB;
constexpr size_t WS_X = WS_WDN + 44 * MiB;
constexpr size_t WS_XB = WS_X + 68 * MiB;
constexpr size_t WS_MIX = WS_XB + 34 * MiB;
constexpr size_t WS_P = WS_MIX + 34 * MiB;
constexpr size_t WS_ACT = WS_P + 221 * MiB;
constexpr size_t WS_HUP = WS_P;
constexpr size_t WS_Y = WS_X;
constexpr size_t WS_DEC = WS_ACT;
constexpr size_t WS_AA = WS_DEC + 34 * MiB;
constexpr size_t WS_KKN = WS_AA + 34 * MiB;
constexpr size_t WS_GG = WS_KKN + 34 * MiB;
constexpr size_t WS_HM = WS_GG + 17 * MiB;
constexpr size_t WS_GATE = WS_HM + 17 * MiB;
constexpr size_t WS_END = WS_GATE + 1 * MiB;

constexpr int LDS_BYTES = 147456;

struct Args { const float* in[35]; float* out; unsigned char* ws; int ph_lo, ph_hi; };

__device__ __forceinline__ unsigned f2bf(float f) { unsigned u = __builtin_bit_cast(unsigned, f); return (u + 0x7fffu + ((u >> 16) & 1u)) >> 16; }
__device__ __forceinline__ unsigned pk2(float lo, float hi) { return f2bf(lo) | (f2bf(hi) << 16); }
__device__ __forceinline__ float bf2f(unsigned short b) { return __builtin_bit_cast(float, ((unsigned)b) << 16); }
__device__ __forceinline__ f32x4 ldp4(const bf16_t* p) { const u32x2 w = *(const u32x2*)p; f32x4 r; r[0] = __builtin_bit_cast(float, w.x << 16); r[1] = __builtin_bit_cast(float, w.x & 0xffff0000u); r[2] = __builtin_bit_cast(float, w.y << 16); r[3] = __builtin_bit_cast(float, w.y & 0xffff0000u); return r; }
__device__ __forceinline__ unsigned cvt_pk_bf16(float lo, float hi) { unsigned r; asm volatile("v_cvt_pk_bf16_f32 %0, %1, %2" : "=v"(r) : "v"(lo), "v"(hi)); return r; }
template <int CTRL> __device__ __forceinline__ float dpp_f(float x) { return __builtin_bit_cast(float, __builtin_amdgcn_update_dpp(0, __builtin_bit_cast(int, x), CTRL, 0xf, 0xf, false)); }
__device__ __forceinline__ float row16_sum(float x) { x += dpp_f<0x128>(x); x += dpp_f<0x124>(x); x += dpp_f<0x122>(x); x += dpp_f<0x121>(x); return x; }
__device__ __forceinline__ float rlane(float x, int l) { return __builtin_bit_cast(float, __builtin_amdgcn_readlane(__builtin_bit_cast(int, x), l)); }
__device__ __forceinline__ float wave_sum(float x) { x = row16_sum(x); return (rlane(x, 0) + rlane(x, 16)) + (rlane(x, 32) + rlane(x, 48)); }
__device__ __forceinline__ float sigmoidf_(float x) { return 1.0f / (1.0f + __expf(-x)); }
__device__ __forceinline__ float gelu_erf(float v) {
    const float av = fabsf(v), t = __builtin_amdgcn_rcpf(av * 0.2316418882f + 1.0f);
    float q = t * 0.5307027145f + (-0.7265760135f); q = q * t + 0.7107068705f; q = q * t + (-0.142248368f); q = q * t + 0.127414796f; q = q * t;
    const float e = __builtin_amdgcn_exp2f((v * v) * (-0.72134752044f));
    const float m = v * (q * e), r = v - m; return v < 0.f ? m : r; }
__device__ __forceinline__ float log1pexp_negabs(float x) { return __logf(1.0f + __expf(-fabsf(x))); }

namespace pg8 {
constexpr int BM = 256, BK = 64, HALF = 128, HTB = HALF * BK * 2, STAGE_BYTES = 8 * HTB, NXCD = 8, WGM = 8;
__host__ __device__ __forceinline__ int lds_byte(int r, int c) { const int st = (r >> 4) * 2 + (c >> 5), rr = r & 15, cc = c & 31, ob = rr * 64 + cc * 2; return st * 1024 + (ob ^ (((ob >> 9) & 1) << 5)); }
__host__ __device__ __forceinline__ void stage_rc(int b, int& R, int& C) { const int st = b / 1024, sb = b % 1024, swz = sb ^ (((sb >> 9) & 1) << 5); R = (st >> 1) * 16 + swz / 64; C = (st & 1) * 32 + (swz % 64) / 2; }
__host__ __device__ __forceinline__ int perm32(int rho) { const int n = rho >> 4, i = rho & 15; return 8 * (i >> 2) + 4 * n + (i & 3); }
struct Unit { int pm, pn, pk; };
struct Gemm { const bf16_t* A; const bf16_t* Bt; int M, N, K, lda, ldb; };
struct StaticOrder {
    int nM, nN, nwg, G, c;
    __device__ void init(int M, int N, int G_, int c_) { nM = M / BM; nN = N / BM; nwg = nM * nN; G = G_; c = c_; }
    __device__ bool next(int i, Unit& u) const {
        const long L = (long)i * G + c; if (L >= nwg) return false;
        int wgid = (int)L; { const int q = nwg / NXCD, r = nwg % NXCD, xcd = wgid % NXCD, off = wgid / NXCD; wgid = (xcd < r ? xcd * (q + 1) : r * (q + 1) + (xcd - r) * q) + off; }
        const int nig = WGM * nN, gid = wgid / nig, fm = gid * WGM, gsz = (nM - fm) < WGM ? (nM - fm) : WGM;
        u.pm = fm + ((wgid % nig) % gsz); u.pn = (wgid % nig) / gsz; u.pk = 0; return true;
    }
};
struct SplitOrder {
    int nM, nN, KS, G, c;
    __device__ void init(int M, int N, int KS_, int G_, int c_) { nM = M / BM; nN = N / BM; KS = KS_; G = G_; c = c_; }
    __device__ bool next(int i, Unit& u) const {
        const int L = i * G + c; if (L >= nM * nN * KS) return false;
        u.pk = L % KS; const int r = L / KS; u.pn = r % nN; u.pm = r / nN; return true;
    }
};
struct EpiP {
    static constexpr bool PERM = false;
    float* C; int ldc; const float* rs;
    __device__ __forceinline__ void operator()(const f32x4 (&acc)[2][2][4][2], const Unit& u, int wr, int wc, int fr, int fq) const {
        const int row0 = u.pm * BM + wr * 64 + fr, col0 = u.pn * BM + wc * 32 + 4 * fq;
#pragma unroll
        for (int ai = 0; ai < 2; ++ai)
#pragma unroll
            for (int m = 0; m < 4; ++m) { const int row = row0 + ai * HALF + m * 16; const float s = rsqrtf(rs[row] * (1.0f / DM) + EPS); float* rowp = C + (size_t)row * ldc + col0;
#pragma unroll
                for (int bj = 0; bj < 2; ++bj)
#pragma unroll
                    for (int n = 0; n < 2; ++n) *(f32x4*)(rowp + bj * HALF + n * 16) = acc[ai][bj][m][n] * s; }
    }
};
struct EpiPart {
    static constexpr bool PERM = false;
    float* C; int mloc;
    __device__ __forceinline__ void operator()(const f32x4 (&acc)[2][2][4][2], const Unit& u, int wr, int wc, int fr, int fq) const {
        const int row0 = u.pm * BM + wr * 64 + fr, col0 = u.pn * BM + wc * 32 + 4 * fq;
#pragma unroll
        for (int ai = 0; ai < 2; ++ai)
#pragma unroll
            for (int m = 0; m < 4; ++m) { const int row = row0 + ai * HALF + m * 16; float* rowp = C + ((size_t)u.pk * mloc + row) * DM + col0;
#pragma unroll
                for (int bj = 0; bj < 2; ++bj)
#pragma unroll
                    for (int n = 0; n < 2; ++n) *(f32x4*)(rowp + bj * HALF + n * 16) = acc[ai][bj][m][n]; }
    }
};
struct EpiUp {
    static constexpr bool PERM = true;
    bf16_t* O; int ldc; const float* rs;
    __device__ __forceinline__ void operator()(const f32x4 (&acc)[2][2][4][2], const Unit& u, int wr, int wc, int fr, int fq) const {
        const int row0 = u.pm * BM + wr * 64 + fr, col0 = u.pn * BM + wc * 32 + 8 * fq;
#pragma unroll
        for (int ai = 0; ai < 2; ++ai)
#pragma unroll
            for (int m = 0; m < 4; ++m) { const int row = row0 + ai * HALF + m * 16; const float s = rsqrtf(rs[row] * (1.0f / DM) + EPS); bf16_t* rowp = O + (size_t)row * ldc + col0;
#pragma unroll
                for (int bj = 0; bj < 2; ++bj) { const f32x4 v0 = acc[ai][bj][m][0] * s, v1 = acc[ai][bj][m][1] * s;
                    u32x4 w; w.x = cvt_pk_bf16(v0[0], v0[1]); w.y = cvt_pk_bf16(v0[2], v0[3]); w.z = cvt_pk_bf16(v1[0], v1[1]); w.w = cvt_pk_bf16(v1[2], v1[3]);
                    *(u32x4*)(rowp + bj * HALF) = w; } }
    }
};
struct EpiRes {
    static constexpr bool PERM = false;
    bf16_t* XB; float* rsn;
    __device__ __forceinline__ void operator()(const f32x4 (&acc)[2][2][4][2], const Unit& u, int wr, int wc, int fr, int fq) const {
        const int row0 = u.pm * BM + wr * 64 + fr, col0 = u.pn * BM + wc * 32 + 4 * fq;
#pragma unroll
        for (int ai = 0; ai < 2; ++ai)
#pragma unroll
            for (int m = 0; m < 4; ++m) { const int row = row0 + ai * HALF + m * 16; bf16_t* rowb = XB + (size_t)row * DM + col0; float ss = 0.f;
#pragma unroll
                for (int bj = 0; bj < 2; ++bj)
#pragma unroll
                    for (int n = 0; n < 2; ++n) { f32x4 x = ldp4(rowb + bj * HALF + n * 16) + acc[ai][bj][m][n];
                        u32x2 w; w.x = cvt_pk_bf16(x[0], x[1]); w.y = cvt_pk_bf16(x[2], x[3]); *(u32x2*)(rowb + bj * HALF + n * 16) = w;
                        ss += (x[0] * x[0] + x[1] * x[1]) + (x[2] * x[2] + x[3] * x[3]); }
                ss += __shfl_xor(ss, 16); ss += __shfl_xor(ss, 32);
                if (fq == 0) unsafeAtomicAdd(rsn + row, ss); }
    }
};

template <class Epi, class Sched>
__device__ __forceinline__ void gemm_phase(LAS unsigned char* lds, const Gemm g, const Sched& S, const Epi& E) {
    int tid = threadIdx.x; asm volatile("" : "+v"(tid)); const int wid = __builtin_amdgcn_readfirstlane(tid >> 6), lane = tid & 63, wr = wid >> 2, wc = wid & 3, fr = lane & 15, fq = lane >> 4;
    const int K = g.K, nt = K / BK;
    unsigned voffA[2], voffB[2];
#pragma unroll
    for (int i = 0; i < 2; ++i) { int R, C; stage_rc(tid * 16 + i * 8192, R, C); const int Rb = Epi::PERM ? ((R & ~31) + perm32(R & 31)) : R;
        voffA[i] = (unsigned)(R * g.lda + C) * 2u; voffB[i] = (unsigned)(Rb * g.ldb + C) * 2u; }
    const size_t kstep = (size_t)(BK * 2);
    const size_t hstepA = (size_t)HALF * g.lda * 2, hstepB = (size_t)HALF * g.ldb * 2;
    const size_t tstepA = 2 * hstepA, tstepB = 2 * hstepB, kofs = (size_t)K * 2;
    const unsigned ldsw = (unsigned)wid * 1024u;
    const int aoff = lds_byte(wr * 64 + fr, fq * 8), boff = lds_byte(wc * 32 + fr, fq * 8);
#define PG8_SA(b, h) (((b) * 2 + (h)) * HTB)
#define PG8_SB(b, h) ((4 + (b) * 2 + (h)) * HTB)
#define PG8_STAGE(bufoff, gbase, voff) do { _Pragma("unroll") for (int _i = 0; _i < 2; ++_i) \
        __builtin_amdgcn_global_load_lds((const unsigned*)((const char*)(gbase) + (voff)[_i]), (LAS unsigned*)(lds + (bufoff) + ldsw + _i * 8192), 16, 0, 0); } while (0)
#define PG8_LDA(dst, b, h) do { _Pragma("unroll") for (int m = 0; m < 4; ++m) _Pragma("unroll") for (int k = 0; k < 2; ++k) dst[m][k] = *(const LAS bf16x8*)(lds + PG8_SA(b, h) + aoff + m * 2048 + k * 1024); } while (0)
#define PG8_LDB(dst, b, h) do { _Pragma("unroll") for (int n = 0; n < 2; ++n) _Pragma("unroll") for (int k = 0; k < 2; ++k) dst[n][k] = *(const LAS bf16x8*)(lds + PG8_SB(b, h) + boff + n * 2048 + k * 1024); } while (0)
#define PG8_MMA(ai, bj, At, Bt) do { __builtin_amdgcn_s_setprio(1); _Pragma("unroll") for (int m = 0; m < 4; ++m) _Pragma("unroll") for (int n = 0; n < 2; ++n) _Pragma("unroll") for (int k = 0; k < 2; ++k) \
        acc[ai][bj][m][n] = __builtin_amdgcn_mfma_f32_16x16x32_bf16(Bt[n][k], At[m][k], acc[ai][bj][m][n], 0, 0, 0); __builtin_amdgcn_s_setprio(0); } while (0)
#define PG8_WAIT_V(n) asm volatile("s_waitcnt vmcnt(" #n ")" ::: "memory")
#define PG8_WAIT_L(n) asm volatile("s_waitcnt lgkmcnt(" #n ")" ::: "memory")
#define PG8_BAR __builtin_amdgcn_s_barrier()
#define PG8_SCHED __builtin_amdgcn_sched_barrier(0)
    Unit cur, nxt; int ui = 0;
    if (!S.next(0, cur)) return;
    f32x4 acc[2][2][4][2];
#pragma unroll
    for (int a = 0; a < 2; ++a)
#pragma unroll
        for (int b = 0; b < 2; ++b)
#pragma unroll
            for (int m = 0; m < 4; ++m)
#pragma unroll
                for (int n = 0; n < 2; ++n) acc[a][b][m][n] = (f32x4){0.f, 0.f, 0.f, 0.f};
    bf16x8 At[4][2], B0[2][2], B1[2][2];
    const char* cA = (const char*)g.A + (size_t)cur.pm * tstepA + (size_t)cur.pk * kofs; const char* cB = (const char*)g.Bt + (size_t)cur.pn * tstepB + (size_t)cur.pk * kofs;
    PG8_STAGE(PG8_SB(0, 0), cB, voffB); PG8_STAGE(PG8_SB(0, 1), cB + hstepB, voffB); PG8_STAGE(PG8_SA(0, 0), cA, voffA); PG8_STAGE(PG8_SA(0, 1), cA + hstepA, voffA);
    if (wr == 1) PG8_BAR;
    PG8_WAIT_V(2); PG8_BAR;
    PG8_STAGE(PG8_SB(1, 0), cB + kstep, voffB); PG8_STAGE(PG8_SA(1, 0), cA + kstep, voffA); PG8_STAGE(PG8_SB(1, 1), cB + hstepB + kstep, voffB);
    PG8_WAIT_V(6); PG8_BAR;
    for (;;) {
        const bool has_next = S.next(ui + 1, nxt);
        const char* nA = has_next ? (const char*)g.A + (size_t)nxt.pm * tstepA + (size_t)nxt.pk * kofs : cA; const char* nB = has_next ? (const char*)g.Bt + (size_t)nxt.pn * tstepB + (size_t)nxt.pk * kofs : cB;
        for (int t = 0; t < nt; t += 2) {
            const bool last = (t == nt - 2);
            const char* a1 = cA + (size_t)(t + 1) * kstep;
            const char* a2 = last ? nA : cA + (size_t)(t + 2) * kstep; const char* b2 = last ? nB : cB + (size_t)(t + 2) * kstep;
            const char* a3 = a2 + kstep; const char* b3 = b2 + kstep;
            PG8_LDB(B0, 0, 0); PG8_LDB(B1, 0, 1); PG8_SCHED; PG8_LDA(At, 0, 0); PG8_STAGE(PG8_SA(1, 1), a1 + hstepA, voffA);
            PG8_WAIT_V(8); PG8_WAIT_L(0); PG8_BAR; PG8_MMA(0, 0, At, B0); PG8_MMA(0, 1, At, B1); PG8_BAR; PG8_SCHED;
            PG8_LDA(At, 0, 1); PG8_STAGE(PG8_SB(0, 0), b2, voffB); PG8_STAGE(PG8_SB(0, 1), b2 + hstepB, voffB); PG8_STAGE(PG8_SA(0, 0), a2, voffA);
            PG8_WAIT_V(8); PG8_WAIT_L(0); PG8_BAR; PG8_MMA(1, 0, At, B0); PG8_MMA(1, 1, At, B1); PG8_BAR; PG8_SCHED;
            PG8_LDB(B0, 1, 0); PG8_LDB(B1, 1, 1); PG8_SCHED; PG8_LDA(At, 1, 0); PG8_STAGE(PG8_SA(0, 1), a2 + hstepA, voffA);
            PG8_WAIT_V(8); PG8_WAIT_L(0); PG8_BAR; PG8_MMA(0, 0, At, B0); PG8_MMA(0, 1, At, B1); PG8_BAR; PG8_SCHED;
            PG8_LDA(At, 1, 1); PG8_STAGE(PG8_SB(1, 0), b3, voffB); PG8_STAGE(PG8_SB(1, 1), b3 + hstepB, voffB); PG8_STAGE(PG8_SA(1, 0), a3, voffA);
            PG8_WAIT_V(8); PG8_WAIT_L(0); PG8_BAR; PG8_MMA(1, 0, At, B0); PG8_MMA(1, 1, At, B1); PG8_BAR; PG8_SCHED;
        }
        if (wr == 0) PG8_BAR;
        E(acc, cur, wr, wc, fr, fq);
        if (!has_next) break;
#pragma unroll
        for (int a = 0; a < 2; ++a)
#pragma unroll
            for (int b = 0; b < 2; ++b)
#pragma unroll
                for (int m = 0; m < 4; ++m)
#pragma unroll
                    for (int n = 0; n < 2; ++n) acc[a][b][m][n] = (f32x4){0.f, 0.f, 0.f, 0.f};
        cur = nxt; cA = nA; cB = nB; ++ui;
        if (wr == 1) PG8_BAR;
    }
    PG8_WAIT_V(0);
    PG8_BAR;
#undef PG8_SA
#undef PG8_SB
#undef PG8_STAGE
#undef PG8_LDA
#undef PG8_LDB
#undef PG8_MMA
#undef PG8_WAIT_V
#undef PG8_WAIT_L
#undef PG8_BAR
#undef PG8_SCHED
}
}

struct Ptrs {
    const Args* a; int l;
};
#define WSP(T, off) ((T*)(A.ws + (off)))
#define INL(i, per) (A.in[i] + (size_t)l * (per))

__device__ __forceinline__ void transpose_item(const float* W, int K, int N, int Npad, bf16_t* WT, const float* gsc, LAS float* scr, int item, int lane) {
    const int nblk = Npad / 32, kb = item / nblk, nb = item % nblk, k0 = 64 * kb, n0 = 32 * nb;
    const int r8 = lane >> 3, n4 = (lane & 7) * 4;
    f32x4 tv[8]; float gv[8];
#pragma unroll
    for (int i = 0; i < 8; ++i) { const int kk = 8 * i + r8; tv[i] = (n0 + n4 < N) ? *(const f32x4*)(W + (size_t)(k0 + kk) * N + n0 + n4) : (f32x4){0.f, 0.f, 0.f, 0.f}; gv[i] = gsc ? gsc[k0 + kk] : 1.0f; }
#pragma unroll
    for (int i = 0; i < 8; ++i) { const int kk = 8 * i + r8; const f32x4 v = tv[i] * gv[i];
        scr[kk * 33 + n4 + 0] = v[0]; scr[kk * 33 + n4 + 1] = v[1]; scr[kk * 33 + n4 + 2] = v[2]; scr[kk * 33 + n4 + 3] = v[3]; }
    asm volatile("s_waitcnt lgkmcnt(0)" ::: "memory");
    const int c = lane & 7;
#pragma unroll
    for (int j = 0; j < 4; ++j) { const int nn = (lane >> 3) + 8 * j; const LAS float* sp = scr + (8 * c) * 33 + nn;
        u32x4 o; o.x = pk2(sp[0 * 33], sp[1 * 33]); o.y = pk2(sp[2 * 33], sp[3 * 33]); o.z = pk2(sp[4 * 33], sp[5 * 33]); o.w = pk2(sp[6 * 33], sp[7 * 33]);
        *(u32x4*)(WT + (size_t)(n0 + nn) * K + k0 + 8 * c) = o; }
    asm volatile("s_waitcnt lgkmcnt(0)" ::: "memory");
}
__device__ __forceinline__ void phase_prologue(const Args& A, LAS unsigned char* lds) {
    int tid = threadIdx.x; asm volatile("" : "+v"(tid)); const int lane = tid & 63, wave = __builtin_amdgcn_readfirstlane(tid >> 6), G = gridDim.x;
    LAS float* scr = (LAS float*)(lds + wave * 16384);
    const int gw = blockIdx.x * 8 + wave, NGW = G * 8;
    constexpr int I_IN = 32 * 208, I_OUT = 32 * 64, I_UP = 32 * 352, I_DN = 88 * 64, I_L = I_IN + I_OUT + I_UP + I_DN;
    for (int it = gw; it < 2 * I_L; it += NGW) {
        const int l = it / I_L; int r = it % I_L;
        if (r < I_IN) { transpose_item(INL(9, (size_t)DM * NIN), DM, NIN, LDP, WSP(bf16_t, WS_WIN) + (size_t)l * LDP * DM, INL(8, DM), scr, r, lane); continue; } r -= I_IN;
        if (r < I_OUT) { transpose_item(INL(28, (size_t)DM * DM), DM, DM, DM, WSP(bf16_t, WS_WOUT) + (size_t)l * DM * DM, nullptr, scr, r, lane); continue; } r -= I_OUT;
        if (r < I_UP) { transpose_item(INL(30, (size_t)DM * DFF2), DM, DFF2, DFF2, WSP(bf16_t, WS_WUP) + (size_t)l * DFF2 * DM, INL(29, DM), scr, r, lane); continue; } r -= I_UP;
        transpose_item(INL(33, (size_t)DFF * DM), DFF, DM, DM, WSP(bf16_t, WS_WDN) + (size_t)l * DM * DFF, nullptr, scr, r, lane);
    }
    bf16_t* XB = WSP(bf16_t, WS_XB); float* RS = WSP(float, WS_CTL);
    for (int row = gw; row < TT; row += NGW) {
        const float* src = row < NPR ? A.in[0] + (size_t)row * DM : A.in[1] + (size_t)(row - NPR) * DM;
        float ss = 0.f;
#pragma unroll
        for (int j = 0; j < 8; ++j) { const f32x4 v = *(const f32x4*)(src + j * 256 + lane * 4);
            u32x2 w; w.x = pk2(v[0], v[1]); w.y = pk2(v[2], v[3]); *(u32x2*)(XB + (size_t)row * DM + j * 256 + lane * 4) = w;
            ss += (v[0] * v[0] + v[1] * v[1]) + (v[2] * v[2] + v[3] * v[3]); }
        ss = wave_sum(ss);
        if (lane == 0) RS[row] = ss;
    }
}

__device__ __forceinline__ f32x4 ld_prev4(const Args& A, int l, const float* P, int row, int col) {
    if (row < NPR) { if ((row & (SEQ - 1)) == 0) return (f32x4){0.f, 0.f, 0.f, 0.f}; return *(const f32x4*)(P + (size_t)(row - 1) * LDP + col); }
    const int s = row - NPR; if ((s & 3) == 0) return *(const f32x4*)(A.in[6] + ((size_t)l * 128 + (s >> 2)) * RWC + (col - RW0));
    return *(const f32x4*)(P + (size_t)(row - 1) * LDP + col);
}
__device__ __forceinline__ f32x2 ld_prev2(const Args& A, int l, const float* P, int row, int col) {
    if (row < NPR) { if ((row & (SEQ - 1)) == 0) return (f32x2){0.f, 0.f}; return *(const f32x2*)(P + (size_t)(row - 1) * LDP + col); }
    const int s = row - NPR; if ((s & 3) == 0) return *(const f32x2*)(A.in[6] + ((size_t)l * 128 + (s >> 2)) * RWC + (col - RW0));
    return *(const f32x2*)(P + (size_t)(row - 1) * LDP + col);
}
__device__ __forceinline__ float ld_prev1(const Args& A, int l, const float* P, int row, int col) {
    if (row < NPR) { if ((row & (SEQ - 1)) == 0) return 0.f; return P[(size_t)(row - 1) * LDP + col]; }
    const int s = row - NPR; if ((s & 3) == 0) return A.in[6][((size_t)l * 128 + (s >> 2)) * RWC + (col - RW0)];
    return P[(size_t)(row - 1) * LDP + col];
}

__device__ __forceinline__ void sgu_prompt(const Args& A, int l, LAS unsigned char* lds, int item);
constexpr int C1_ROWS = 34;
__device__ __forceinline__ void phase_c1(const Args& A, int l, LAS unsigned char* lds) {
    int tid = threadIdx.x; asm volatile("" : "+v"(tid)); const int lane = tid & 63, wave = tid >> 6, G = gridDim.x;
    const float* P = WSP(float, WS_P);
    const float* mu = INL(13, RWC);
    LAS float* in_s = (LAS float*)lds;
    float* DEC = WSP(float, WS_DEC); float* AAp = WSP(float, WS_AA); float* KKN = WSP(float, WS_KKN); bf16_t* GG = WSP(bf16_t, WS_GG);
    const float* w_up = INL(15, 64 * 1024); const float* a_up = INL(17, 64 * 1024); const float* g_up = INL(18, 128 * 1024);
    const int c0 = tid * 2;
    for (int tile = blockIdx.x; tile < TT / C1_ROWS; tile += G) {
        const int row0 = tile * C1_ROWS;
        __syncthreads();
        for (int idx = tid; idx < C1_ROWS * 64; idx += 512) {
            const int rr = idx >> 6, c4 = (idx & 63) * 4, row = row0 + rr;
            const f32x4 pf = *(const f32x4*)(P + (size_t)row * LDP + RW_LW + c4);
            const f32x4 pv = ld_prev4(A, l, P, row, RW_LW + c4);
            const f32x4 m4 = *(const f32x4*)(mu + (RW_LW - RW0) + c4);
            f32x4 px = pf + (pv - pf) * m4;
            if (c4 < 64) { for (int e = 0; e < 4; ++e) { const float ex = __expf(-2.0f * fabsf(px[e])); const float th = (1.0f - ex) / (1.0f + ex); px[e] = px[e] < 0.f ? -th : th; } }
            else if (c4 >= 128) { px[0] = sigmoidf_(px[0]); px[1] = sigmoidf_(px[1]); px[2] = sigmoidf_(px[2]); px[3] = sigmoidf_(px[3]); }
            *(LAS f32x4*)(in_s + rr * 256 + c4) = px;
        }
        __syncthreads();
#define C1_LORA(WPTR, NJ4, INOFF) { f32x2 wn[4]; \
            _Pragma("unroll") for (int i = 0; i < 4; ++i) wn[i] = *(const f32x2*)((WPTR) + (size_t)i * 1024 + c0); \
            for (int j4 = 0; j4 < (NJ4); ++j4) { f32x2 wv[4]; \
                _Pragma("unroll") for (int i = 0; i < 4; ++i) wv[i] = wn[i]; \
                const int jn = (j4 + 1 < (NJ4)) ? j4 + 1 : j4; \
                _Pragma("unroll") for (int i = 0; i < 4; ++i) wn[i] = *(const f32x2*)((WPTR) + (size_t)(jn * 4 + i) * 1024 + c0); \
                _Pragma("unroll") for (int t = 0; t < C1_ROWS; ++t) { const f32x4 x = *(const LAS f32x4*)(in_s + t * 256 + (INOFF) + j4 * 4); \
                    acc[t] += wv[0] * x[0]; acc[t] += wv[1] * x[1]; acc[t] += wv[2] * x[2]; acc[t] += wv[3] * x[3]; } } }
        {
            f32x2 acc[C1_ROWS];
            const f32x2 b0 = *(const f32x2*)(INL(14, 1024) + c0);
#pragma unroll
            for (int t = 0; t < C1_ROWS; ++t) acc[t] = b0;
            C1_LORA(w_up, 16, 0)
#pragma unroll
            for (int t = 0; t < C1_ROWS; ++t) { f32x2 o;
#pragma unroll
                for (int e = 0; e < 2; ++e) { const float wl = acc[t][e]; const float z = -wl; const float sp = fmaxf(z, 0.f) + log1pexp_negabs(z); const float wlog = -sp - 0.5f; o[e] = __expf(-__expf(wlog)); }
                *(f32x2*)(DEC + (size_t)(row0 + t) * 1024 + c0) = o; }
        }
        {
            f32x2 acc[C1_ROWS];
            const f32x2 b0 = *(const f32x2*)(INL(16, 1024) + c0);
#pragma unroll
            for (int t = 0; t < C1_ROWS; ++t) acc[t] = b0;
            C1_LORA(a_up, 16, 64)
#pragma unroll
            for (int t = 0; t < C1_ROWS; ++t) { f32x2 o; o[0] = sigmoidf_(acc[t][0]); o[1] = sigmoidf_(acc[t][1]); *(f32x2*)(AAp + (size_t)(row0 + t) * 1024 + c0) = o; }
        }
        {
            f32x2 acc[C1_ROWS];
#pragma unroll
            for (int t = 0; t < C1_ROWS; ++t) acc[t] = (f32x2){0.f, 0.f};
            C1_LORA(g_up, 32, 128)
#pragma unroll
            for (int t = 0; t < C1_ROWS; ++t) *(unsigned*)(GG + (size_t)(row0 + t) * 1024 + c0) = pk2(acc[t][0], acc[t][1]);
        }
#undef C1_LORA
        {
            const f32x2 kk2 = *(const f32x2*)(INL(19, 1024) + c0);
            const f32x2 mk = *(const f32x2*)(mu + (RW_K - RW0) + c0);
            for (int th = 0; th < 2; ++th) {
                f32x2 pf[17], pv[17];
#pragma unroll
                for (int t = 0; t < 17; ++t) { const int row = row0 + th * 17 + t; pf[t] = *(const f32x2*)(P + (size_t)row * LDP + RW_K + c0); pv[t] = ld_prev2(A, l, P, row, RW_K + c0); }
#pragma unroll
                for (int t = 0; t < 17; ++t) { const int row = row0 + th * 17 + t;
                    const f32x2 k = pf[t] + (pv[t] - pf[t]) * mk; f32x2 kk = k * kk2;
                    float ss = kk[0] * kk[0] + kk[1] * kk[1]; ss = row16_sum(ss); ss += __shfl_xor(ss, 16);
                    const float inv = rsqrtf(fmaxf(ss, 1e-24f));
                    *(f32x2*)(KKN + (size_t)row * 1024 + c0) = kk * inv; }
            }
        }
    }
    {
        f32x4* GATE = WSP(f32x4, WS_GATE);
        const float* b_i = INL(10, 4); const float* b_f = INL(11, 4);
        const int gw = blockIdx.x * 8 + wave, NGW = G * 8;
        for (int it = gw; it < (TT / 64) * 4; it += NGW) {
            const int h = it & 3, ch = it >> 2, row = ch * 64 + lane;
            const int segl = row < NPR ? 64 : 4;
            const float ig = P[(size_t)row * LDP + ML_IG + h] + b_i[h];
            const float fp = P[(size_t)row * LDP + ML_FG + h] + b_f[h];
            const float lf = fminf(fp, 0.f) - log1pexp_negabs(fp);
            float b = lf;
            for (int off = 1; off < segl; off <<= 1) { const float v = __shfl_up(b, off); if ((lane & (segl - 1)) >= off) b += v; }
            const float c = ig - b; float pm = c;
            for (int off = 1; off < segl; off <<= 1) { const float v = __shfl_up(pm, off); if ((lane & (segl - 1)) >= off) pm = fmaxf(pm, v); }
            GATE[(size_t)row * 4 + h] = (f32x4){c, pm, b, 0.f};
        }
    }
}

__device__ __forceinline__ float row8_sum(float x) { x += dpp_f<0xB1>(x); x += dpp_f<0x4E>(x); x += dpp_f<0x141>(x); return x; }
#define LO2(v) __builtin_shufflevector(v, v, 0, 1)
#define HI2(v) __builtin_shufflevector(v, v, 2, 3)
__device__ __forceinline__ void rwkv_prompt(const Args& A, int l, LAS unsigned char* lds, int item) {
    int tid = threadIdx.x; asm volatile("" : "+v"(tid)); const int lane = tid & 63, wave = tid >> 6;
    const int bh = item >> 1, b = bh >> 4, h = bh & 15, v0 = (item & 1) * 32, rowbase = b * SEQ;
    const int rr = lane >> 3, j = lane & 7, pi = (wave & 3) * 8 + rr, vrow = v0 + pi;
    const bool cwave = wave < 4;
    const float* P = WSP(float, WS_P);
    const float* DEC = WSP(float, WS_DEC); const float* AAp = WSP(float, WS_AA); const float* KKN = WSP(float, WS_KKN); float* Y = WSP(float, WS_Y);
    const float* mu = INL(13, RWC);
    LAS float* buf = (LAS float*)lds;
    LAS float* ybuf = buf + 2 * 6 * 32 * 64;
    constexpr int NB = SEQ / 32;
    f32x2 S0 = (f32x2){0.f, 0.f}, S1 = S0, S2 = S0, S3 = S0;
    const int pt = tid & 255, jj = pt & 15, tok0 = pt >> 4, ch = h * 64 + 4 * jj;
    const f32x4 mu_r = *(const f32x4*)(mu + (RW_R - RW0) + ch), mu_k = *(const f32x4*)(mu + (RW_K - RW0) + ch), mu_v = *(const f32x4*)(mu + (RW_V - RW0) + ch);
    const f32x4 ka = *(const f32x4*)(INL(20, 1024) + ch);
    f32x4 pr[2], pk[2], pv[2], qr[2], qk[2], qv[2], dd[2], aa[2], kn[2];
#define RW_LOAD(bt) do { _Pragma("unroll") for (int u_ = 0; u_ < 2; ++u_) { const int row_ = rowbase + (bt) * 32 + tok0 + 16 * u_; \
        pr[u_] = *(const f32x4*)(P + (size_t)row_ * LDP + RW_R + ch); pk[u_] = *(const f32x4*)(P + (size_t)row_ * LDP + RW_K + ch); pv[u_] = *(const f32x4*)(P + (size_t)row_ * LDP + RW_V + ch); \
        qr[u_] = ld_prev4(A, l, P, row_, RW_R + ch); qk[u_] = ld_prev4(A, l, P, row_, RW_K + ch); qv[u_] = ld_prev4(A, l, P, row_, RW_V + ch); \
        dd[u_] = *(const f32x4*)(DEC + (size_t)row_ * 1024 + ch); aa[u_] = *(const f32x4*)(AAp + (size_t)row_ * 1024 + ch); kn[u_] = *(const f32x4*)(KKN + (size_t)row_ * 1024 + ch); } } while (0)
#define RW_STAGE(bt) do { LAS float* bw_ = buf + ((bt) & 1) * (6 * 32 * 64); _Pragma("unroll") for (int u_ = 0; u_ < 2; ++u_) { const int tok_ = tok0 + 16 * u_; \
        const f32x4 r_ = pr[u_] + (qr[u_] - pr[u_]) * mu_r, k_ = pk[u_] + (qk[u_] - pk[u_]) * mu_k, v_ = pv[u_] + (qv[u_] - pv[u_]) * mu_v; \
        const f32x4 k2_ = k_ * (1.0f + (aa[u_] - 1.0f) * ka); \
        *(LAS f32x4*)(bw_ + (0 * 32 + tok_) * 64 + 4 * jj) = dd[u_]; *(LAS f32x4*)(bw_ + (1 * 32 + tok_) * 64 + 4 * jj) = -kn[u_]; *(LAS f32x4*)(bw_ + (2 * 32 + tok_) * 64 + 4 * jj) = kn[u_] * aa[u_]; \
        *(LAS f32x4*)(bw_ + (3 * 32 + tok_) * 64 + 4 * jj) = k2_; *(LAS f32x4*)(bw_ + (4 * 32 + tok_) * 64 + 4 * jj) = r_; *(LAS f32x4*)(bw_ + (5 * 32 + tok_) * 64 + 4 * jj) = v_; } } while (0)
#define RW_FLUSH(btx) do { _Pragma("unroll") for (int u_ = 0; u_ < 2; ++u_) { const int i_ = pt + 256 * u_, s_ = i_ >> 4, c2_ = (i_ & 15) * 2; const f32x2 yv_ = *(const LAS f32x2*)(ybuf + ((btx) & 1) * 1024 + s_ * 32 + c2_); \
        *(f32x2*)(Y + (size_t)(rowbase + (btx) * 32 + s_) * 1024 + h * 64 + v0 + c2_) = yv_; } } while (0)
    __syncthreads();
    if (!cwave) { RW_LOAD(0); RW_STAGE(0); RW_LOAD(1); }
    __syncthreads();
    for (int bt = 0; bt < NB; ++bt) {
        if (cwave) {
            const LAS float* bb = buf + (bt & 1) * (6 * 32 * 64);
            LAS float* yb = ybuf + (bt & 1) * 1024;
            const LAS float* bj = bb + 8 * j;
            const LAS float* bv = bb + (5 * 32) * 64 + vrow;
#define RW_LD8(vec, st, lo, hi) const f32x4 lo = *(const LAS f32x4*)(bj + ((vec) * 32 + (st)) * 64), hi = *(const LAS f32x4*)(bj + ((vec) * 32 + (st)) * 64 + 4)
            f32x4 cw0, cw1, ca0, ca1, cb0, cb1, ck0, ck1, cr0, cr1; float cv;
            { RW_LD8(0, 0, a_, b_); cw0 = a_; cw1 = b_; } { RW_LD8(1, 0, a_, b_); ca0 = a_; ca1 = b_; } { RW_LD8(2, 0, a_, b_); cb0 = a_; cb1 = b_; }
            { RW_LD8(3, 0, a_, b_); ck0 = a_; ck1 = b_; } { RW_LD8(4, 0, a_, b_); cr0 = a_; cr1 = b_; } cv = bv[0];
#pragma unroll 8
            for (int s = 0; s < 32; ++s) {
                const int sn = (s + 1) & 31;
                RW_LD8(0, sn, nw0, nw1); RW_LD8(1, sn, na0, na1); RW_LD8(2, sn, nb0, nb1); RW_LD8(3, sn, nk0, nk1); RW_LD8(4, sn, nr0, nr1); const float nv = bv[sn * 64];
                f32x2 t2 = S0 * LO2(ca0); t2 += S1 * HI2(ca0); t2 += S2 * LO2(ca1); t2 += S3 * HI2(ca1);
                const float sa = row8_sum(t2[0] + t2[1]);
                S0 = S0 * LO2(cw0) + LO2(ck0) * cv; S1 = S1 * HI2(cw0) + HI2(ck0) * cv; S2 = S2 * LO2(cw1) + LO2(ck1) * cv; S3 = S3 * HI2(cw1) + HI2(ck1) * cv;
                S0 += LO2(cb0) * sa; S1 += HI2(cb0) * sa; S2 += LO2(cb1) * sa; S3 += HI2(cb1) * sa;
                f32x2 u2 = S0 * LO2(cr0); u2 += S1 * HI2(cr0); u2 += S2 * LO2(cr1); u2 += S3 * HI2(cr1);
                const float y = row8_sum(u2[0] + u2[1]);
                yb[s * 32 + pi] = y;
                cw0 = nw0; cw1 = nw1; ca0 = na0; ca1 = na1; cb0 = nb0; cb1 = nb1; ck0 = nk0; ck1 = nk1; cr0 = nr0; cr1 = nr1; cv = nv;
            }
#undef RW_LD8
        } else {
            if (bt + 1 < NB) RW_STAGE(bt + 1);
            if (bt + 2 < NB) RW_LOAD(bt + 2);
            if (bt > 0) RW_FLUSH(bt - 1);
        }
        __syncthreads();
    }
    if (!cwave) RW_FLUSH(NB - 1);
#undef RW_LOAD
#undef RW_STAGE
#undef RW_FLUSH
    if (cwave) {
        float* So = A.out + O_SP + (size_t)((l * 4 + b) * 16 + h) * 64 * 64 + (size_t)vrow * 64 + 8 * j;
        *(f32x4*)(So) = (f32x4){S0[0], S0[1], S1[0], S1[1]};
        *(f32x4*)(So + 4) = (f32x4){S2[0], S2[1], S3[0], S3[1]};
    }
    __syncthreads();
}
__device__ __forceinline__ void rwkv_sample2(const Args& A, int l, LAS unsigned char* lds, int item) {
    int tid = threadIdx.x; asm volatile("" : "+v"(tid)); const int lane = tid & 63, wave = tid >> 6;
    const int b = item >> 3, h0 = (item & 7) * 2, rowbase = NPR + b * 4;
    const int rr = lane >> 4, j = lane & 15;
    const float* P = WSP(float, WS_P);
    const float* DEC = WSP(float, WS_DEC); const float* AAp = WSP(float, WS_AA); const float* KKN = WSP(float, WS_KKN); float* Y = WSP(float, WS_Y);
    const float* mu = INL(13, RWC);
    LAS float* buf = (LAS float*)lds;
    const float* S0 = A.in[5] + (size_t)((l * 128 + b) * 16 + h0) * 64 * 64;
    float* So = A.out + O_SS + (size_t)((l * 128 + b) * 16 + h0) * 64 * 64;
    f32x4 S[4];
#pragma unroll
    for (int q = 0; q < 4; ++q) { const int vrow = (q & 1) * 32 + wave * 4 + rr; S[q] = *(const f32x4*)(S0 + (size_t)(q >> 1) * 4096 + (size_t)vrow * 64 + 4 * j); }
    if (tid < 128) {
        const int hd = tid >> 6, tok = (tid >> 4) & 3, jj = tid & 15, ch = (h0 + hd) * 64 + 4 * jj, row = rowbase + tok;
        const f32x4 mu_r = *(const f32x4*)(mu + (RW_R - RW0) + ch), mu_k = *(const f32x4*)(mu + (RW_K - RW0) + ch), mu_v = *(const f32x4*)(mu + (RW_V - RW0) + ch);
        const f32x4 ka = *(const f32x4*)(INL(20, 1024) + ch);
        const f32x4 pr = *(const f32x4*)(P + (size_t)row * LDP + RW_R + ch), pk = *(const f32x4*)(P + (size_t)row * LDP + RW_K + ch), pv = *(const f32x4*)(P + (size_t)row * LDP + RW_V + ch);
        const f32x4 qr = ld_prev4(A, l, P, row, RW_R + ch), qk = ld_prev4(A, l, P, row, RW_K + ch), qv = ld_prev4(A, l, P, row, RW_V + ch);
        const f32x4 dd = *(const f32x4*)(DEC + (size_t)row * 1024 + ch), aa = *(const f32x4*)(AAp + (size_t)row * 1024 + ch), kn = *(const f32x4*)(KKN + (size_t)row * 1024 + ch);
        const f32x4 r = pr + (qr - pr) * mu_r, k = pk + (qk - pk) * mu_k, v = pv + (qv - pv) * mu_v;
        const f32x4 k2 = k * (1.0f + (aa - 1.0f) * ka);
        LAS float* bb = buf + hd * (6 * 4 * 64);
        *(LAS f32x4*)(bb + (0 * 4 + tok) * 64 + 4 * jj) = dd;
        *(LAS f32x4*)(bb + (1 * 4 + tok) * 64 + 4 * jj) = -kn;
        *(LAS f32x4*)(bb + (2 * 4 + tok) * 64 + 4 * jj) = kn * aa;
        *(LAS f32x4*)(bb + (3 * 4 + tok) * 64 + 4 * jj) = k2;
        *(LAS f32x4*)(bb + (4 * 4 + tok) * 64 + 4 * jj) = r;
        *(LAS f32x4*)(bb + (5 * 4 + tok) * 64 + 4 * jj) = v;
    }
    __syncthreads();
#pragma unroll
    for (int t = 0; t < 4; ++t) {
#pragma unroll
        for (int q = 0; q < 4; ++q) { const int hd = q >> 1, vrow = (q & 1) * 32 + wave * 4 + rr; const LAS float* bb = buf + hd * (6 * 4 * 64);
            const f32x4 w4 = *(const LAS f32x4*)(bb + (0 * 4 + t) * 64 + 4 * j), a4 = *(const LAS f32x4*)(bb + (1 * 4 + t) * 64 + 4 * j), b4 = *(const LAS f32x4*)(bb + (2 * 4 + t) * 64 + 4 * j),
                        k4 = *(const LAS f32x4*)(bb + (3 * 4 + t) * 64 + 4 * j), r4 = *(const LAS f32x4*)(bb + (4 * 4 + t) * 64 + 4 * j); const float vv = bb[(5 * 4 + t) * 64 + vrow];
            float sa = (S[q][0] * a4[0] + S[q][1] * a4[1]) + (S[q][2] * a4[2] + S[q][3] * a4[3]);
            sa = row16_sum(sa);
            S[q] = S[q] * w4 + k4 * vv;
            S[q] = S[q] + b4 * sa;
            float y = (S[q][0] * r4[0] + S[q][1] * r4[1]) + (S[q][2] * r4[2] + S[q][3] * r4[3]);
            y = row16_sum(y);
            if (j == 0) Y[(size_t)(rowbase + t) * 1024 + (h0 + hd) * 64 + vrow] = y; }
    }
#pragma unroll
    for (int q = 0; q < 4; ++q) { const int vrow = (q & 1) * 32 + wave * 4 + rr; *(f32x4*)(So + (size_t)(q >> 1) * 4096 + (size_t)vrow * 64 + 4 * j) = S[q]; }
    __syncthreads();
}

__device__ __forceinline__ void mlstm_prompt(const Args& A, int l, LAS unsigned char* lds, int bh, int half) {
    int tid = threadIdx.x; asm volatile("" : "+v"(tid)); const int lane = tid & 63, wave = __builtin_amdgcn_readfirstlane(tid >> 6), fr = lane & 15, fq = lane >> 4;
    const int b = bh >> 2, h = bh & 3, eo = half * 4;
    const float* P = WSP(float, WS_P); const f32x4* GATE = WSP(f32x4, WS_GATE); float* HM = WSP(float, WS_HM);
    LAS bf16_t* Qs = (LAS bf16_t*)(lds);
    LAS bf16_t* Ks = (LAS bf16_t*)(lds + 17408);
    LAS bf16_t* Vt = (LAS bf16_t*)(lds + 34816);
    LAS bf16_t* Kwt = (LAS bf16_t*)(lds + 55552);
    LAS bf16_t* Ct = (LAS bf16_t*)(lds + 73984);
    LAS bf16_t* Att = (LAS bf16_t*)(lds + 113152);
    LAS float* gf = (LAS float*)(lds + 122368);
    LAS float *cs = gf, *Mt = gf + 64, *si = gf + 128, *fl = gf + 192, *den = gf + 256, *wk = gf + 320, *misc = gf + 384;
    __syncthreads();
    for (int i = tid; i < 144 * 136 / 2; i += 512) ((LAS unsigned*)Ct)[i] = 0u;
    for (int i = tid; i < 64 * 72 / 2; i += 512) ((LAS unsigned*)Att)[i] = 0u;
    for (int i = tid; i < 16 * 72; i += 512) Vt[64 * 72 + i] = (i < 64) ? (bf16_t)0x3F80 : (bf16_t)0;
    f32x4 cacc[5];
#pragma unroll
    for (int e = 0; e < 5; ++e) cacc[e] = (f32x4){0.f, 0.f, 0.f, 0.f};
    float m = 0.f;
    const float kscale = 0.08838834764831845f;
    f32x4 nq[4], nk[4], nv[4]; f32x4 gnx = (f32x4){0.f, 0.f, 0.f, 0.f};
#define ML_SWZ(r, cchunk) ((((cchunk) ^ (((r) >> 2) & 7))) << 3)
#define ML_LOAD(c) do { if (tid < 64) gnx = GATE[(size_t)(b * SEQ + (c) * 64 + tid) * 4 + h];  const int row0_ = b * SEQ + (c) * 64; _Pragma("unroll") for (int i = 0; i < 4; ++i) { const int idx = tid + i * 512, t = idx >> 5, d4 = (idx & 31) * 4; const float* pp = P + (size_t)(row0_ + t) * LDP + h * 128 + d4; \
        nq[i] = *(const f32x4*)(pp + ML_Q); nk[i] = *(const f32x4*)(pp + ML_K); nv[i] = *(const f32x4*)(pp + ML_V); } } while (0)
    ML_LOAD(0);
    __syncthreads();
    for (int c = 0; c < 32; ++c) {
        const int row0 = b * SEQ + c * 64;
        if (tid < 64) {
            const f32x4 g = gnx;
            const float M = fmaxf(m, g[1]);
            cs[tid] = g[0]; Mt[tid] = M; si[tid] = __expf(m - M); fl[tid] = __expf(-(g[2] + M));
            const float M63 = rlane(M, 63), b63 = rlane(g[2], 63);
            wk[tid] = __expf(g[0] - M63);
            if (tid == 0) misc[0] = b63 + M63;
        }
        __syncthreads();
        m = misc[0];
#pragma unroll
        for (int i = 0; i < 4; ++i) { const int idx = tid + i * 512, t = idx >> 5, d4 = (idx & 31) * 4; const float w = wk[t];
            u32x2 q2; q2.x = pk2(nq[i][0], nq[i][1]); q2.y = pk2(nq[i][2], nq[i][3]); *(LAS u32x2*)(Qs + t * 136 + d4) = q2;
            const f32x4 ks = nk[i] * kscale;
            u32x2 k2; k2.x = pk2(ks[0], ks[1]); k2.y = pk2(ks[2], ks[3]); *(LAS u32x2*)(Ks + t * 136 + d4) = k2;
#pragma unroll
            for (int e = 0; e < 4; ++e) { const int sw = (d4 + e) * 72 + ML_SWZ(d4 + e, t >> 3) + (t & 7); Kwt[sw] = (bf16_t)f2bf(ks[e] * w);
                if ((d4 >> 6) == half) { const int rl_ = (d4 & 63) + e; Vt[rl_ * 72 + ML_SWZ(rl_, t >> 3) + (t & 7)] = (bf16_t)f2bf(nv[i][e]); } } }
        __syncthreads();
        if (c + 1 < 32) ML_LOAD(c + 1);
        for (int tl = wave; tl < 10; tl += 8) {
            int ti, sj; if (tl < 1) { ti = 0; sj = 0; } else if (tl < 3) { ti = 1; sj = tl - 1; } else if (tl < 6) { ti = 2; sj = tl - 3; } else { ti = 3; sj = tl - 6; }
            f32x4 acc = (f32x4){0.f, 0.f, 0.f, 0.f};
#pragma unroll
            for (int ks = 0; ks < 4; ++ks) { const bf16x8 a = *(const LAS bf16x8*)(Qs + (ti * 16 + fr) * 136 + ks * 32 + fq * 8); const bf16x8 bb = *(const LAS bf16x8*)(Ks + (sj * 16 + fr) * 136 + ks * 32 + fq * 8);
                acc = __builtin_amdgcn_mfma_f32_16x16x32_bf16(a, bb, acc, 0, 0, 0); }
            const int s = sj * 16 + fr; const float csv = cs[s];
#pragma unroll
            for (int jx = 0; jx < 4; ++jx) { const int t = ti * 16 + fq * 4 + jx; const float v = (s <= t) ? acc[jx] * __expf(csv - Mt[t]) : 0.f; Att[t * 72 + s] = (bf16_t)f2bf(v); }
        }
        __syncthreads();
        const int ti = wave & 3, e0 = (wave >> 2) ? 3 : 0, e1 = (wave >> 2) ? 5 : 3;
        f32x4 o[3];
        {
            bf16x8 qa[4], aa2[2];
#pragma unroll
            for (int ks = 0; ks < 4; ++ks) qa[ks] = *(const LAS bf16x8*)(Qs + (ti * 16 + fr) * 136 + ks * 32 + fq * 8);
#pragma unroll
            for (int ks = 0; ks < 2; ++ks) aa2[ks] = *(const LAS bf16x8*)(Att + (ti * 16 + fr) * 72 + ks * 32 + fq * 8);
            float sv[4];
#pragma unroll
            for (int jx = 0; jx < 4; ++jx) sv[jx] = si[ti * 16 + fq * 4 + jx];
#pragma unroll
            for (int ei = 0; ei < 3; ++ei) { const int et = e0 + ei; if (et < e1) {
                f32x4 acc = (f32x4){0.f, 0.f, 0.f, 0.f};
#pragma unroll
                for (int ks = 0; ks < 4; ++ks) { const bf16x8 bb = *(const LAS bf16x8*)(Ct + (et * 16 + fr) * 136 + ks * 32 + fq * 8); acc = __builtin_amdgcn_mfma_f32_16x16x32_bf16(qa[ks], bb, acc, 0, 0, 0); }
#pragma unroll
                for (int jx = 0; jx < 4; ++jx) acc[jx] *= sv[jx];
#pragma unroll
                for (int ks = 0; ks < 2; ++ks) { const bf16x8 bb = *(const LAS bf16x8*)(Vt + (et * 16 + fr) * 72 + ML_SWZ(et * 16 + fr, ks * 4 + fq)); acc = __builtin_amdgcn_mfma_f32_16x16x32_bf16(aa2[ks], bb, acc, 0, 0, 0); }
                o[ei] = acc;
                if (et == 4 && fr == 0) {
#pragma unroll
                    for (int jx = 0; jx < 4; ++jx) den[ti * 16 + fq * 4 + jx] = acc[jx]; }
            } }
        }
        __syncthreads();
        {
            float dn[4];
#pragma unroll
            for (int jx = 0; jx < 4; ++jx) { const int t = ti * 16 + fq * 4 + jx; dn[jx] = 1.0f / fmaxf(fabsf(den[t]), fl[t]); }
#pragma unroll
            for (int ei = 0; ei < 3; ++ei) { const int et = e0 + ei; if (et < e1 && et < 4) {
#pragma unroll
                for (int jx = 0; jx < 4; ++jx) { const int t = ti * 16 + fq * 4 + jx; HM[(size_t)(row0 + t) * 512 + h * 128 + (eo + et) * 16 + fr] = o[ei][jx] * dn[jx]; } } }
        }
        {
            const float dec = si[63];
            bf16x8 kb[2];
#pragma unroll
            for (int ks = 0; ks < 2; ++ks) kb[ks] = *(const LAS bf16x8*)(Kwt + (wave * 16 + fr) * 72 + ML_SWZ(wave * 16 + fr, ks * 4 + fq));
#pragma unroll
            for (int et = 0; et < 5; ++et) { f32x4 acc = cacc[et] * dec;
#pragma unroll
                for (int ks = 0; ks < 2; ++ks) { const bf16x8 va = *(const LAS bf16x8*)(Vt + (et * 16 + fr) * 72 + ML_SWZ(et * 16 + fr, ks * 4 + fq)); acc = __builtin_amdgcn_mfma_f32_16x16x32_bf16(va, kb[ks], acc, 0, 0, 0); }
                cacc[et] = acc;
#pragma unroll
                for (int jx = 0; jx < 4; ++jx) Ct[(et * 16 + fq * 4 + jx) * 136 + wave * 16 + fr] = (bf16_t)f2bf(acc[jx]); }
        }
        __syncthreads();
    }
#undef ML_LOAD
#undef ML_SWZ
    {
        float* Co = A.out + O_CP + (size_t)((l * 4 + b) * 4 + h) * 128 * 128;
        const int d = wave * 16 + fr;
#pragma unroll
        for (int et = 0; et < 4; ++et) *(f32x4*)(Co + (size_t)d * 128 + (eo + et) * 16 + fq * 4) = cacc[et];
        if (fq == 0 && half == 0) A.out[O_NP + (size_t)((l * 4 + b) * 4 + h) * 128 + d] = cacc[4][0];
        if (tid == 0 && half == 0) A.out[O_MP + (l * 4 + b) * 4 + h] = m;
    }
    __syncthreads();
}

__device__ __forceinline__ void mlstm_sample(const Args& A, int l, LAS unsigned char* lds, int item) {
    int tid = threadIdx.x; asm volatile("" : "+v"(tid)); const int lane = tid & 63, wave = tid >> 6;
    const int b = item >> 2, h = item & 3, row0 = NPR + b * 4;
    const float* P = WSP(float, WS_P); const f32x4* GATE = WSP(f32x4, WS_GATE); float* HM = WSP(float, WS_HM);
    LAS float* q = (LAS float*)lds;
    LAS float* k = q + 512;
    LAS float* v = k + 512;
    LAS float* att = v + 512;
    LAS float* gv = att + 16;
    LAS float* qn = gv + 32;
    LAS float* qc = qn + 32;
    const float* C0 = A.in[2] + (size_t)((l * 128 + b) * 4 + h) * 128 * 128;
    const float* n0 = A.in[3] + (size_t)((l * 128 + b) * 4 + h) * 128;
    const float m0 = A.in[4][(l * 128 + b) * 4 + h];
    const int rg = tid >> 5, e4 = (tid & 31) * 4;
    f32x4 cv[8];
#pragma unroll
    for (int p = 0; p < 8; ++p) cv[p] = *(const f32x4*)(C0 + (size_t)(p * 16 + rg) * 128 + e4);
    __syncthreads();
    { const int t = tid >> 7, d = tid & 127; const float* pp = P + (size_t)(row0 + t) * LDP + h * 128 + d;
      q[tid] = pp[ML_Q]; k[tid] = pp[ML_K] * 0.08838834764831845f; v[tid] = pp[ML_V]; }
    if (tid < 4) {
        const f32x4 g = GATE[(size_t)(row0 + tid) * 4 + h]; const float M = fmaxf(m0, g[1]);
        gv[tid] = __expf(m0 - M); gv[4 + tid] = __expf(-(g[2] + M)); gv[12 + tid] = g[0]; gv[16 + tid] = M;
        const float M3 = rlane(M, 3), b3 = rlane(g[2], 3);
        gv[8 + tid] = __expf(g[0] - M3);
        if (tid == 0) { gv[20] = __expf(m0 - M3); gv[21] = b3 + M3; }
    }
    __syncthreads();
    for (int pr = wave; pr < 16; pr += 8) { const int t = pr >> 2, s2 = pr & 3;
        float d = q[t * 128 + lane] * k[s2 * 128 + lane] + q[t * 128 + 64 + lane] * k[s2 * 128 + 64 + lane]; d = wave_sum(d);
        if (lane == 0) att[pr] = (s2 <= t) ? d * __expf(gv[12 + s2] - gv[16 + t]) : 0.f; }
    const float dec = gv[20];
    f32x4 v4[4]; float wkv[4];
#pragma unroll
    for (int s2 = 0; s2 < 4; ++s2) { wkv[s2] = gv[8 + s2]; v4[s2] = *(const LAS f32x4*)(v + s2 * 128 + e4); }
    f32x4 acc[4];
#pragma unroll
    for (int t = 0; t < 4; ++t) acc[t] = (f32x4){0.f, 0.f, 0.f, 0.f};
    float* Co = A.out + O_CS + (size_t)((l * 128 + b) * 4 + h) * 128 * 128;
#pragma unroll
    for (int p = 0; p < 8; ++p) { const int d = p * 16 + rg; f32x4 cn = cv[p] * dec;
#pragma unroll
        for (int s2 = 0; s2 < 4; ++s2) { acc[s2] += cv[p] * q[s2 * 128 + d]; cn += v4[s2] * (wkv[s2] * k[s2 * 128 + d]); }
        *(f32x4*)(Co + (size_t)d * 128 + e4) = cn; }
#pragma unroll
    for (int t = 0; t < 4; ++t) *(LAS f32x4*)(qc + (rg * 4 + t) * 128 + e4) = acc[t];
    if (tid < 128) { const float nv0 = n0[tid]; float nn = dec * nv0;
#pragma unroll
        for (int s2 = 0; s2 < 4; ++s2) nn += wkv[s2] * k[s2 * 128 + tid];
        A.out[O_NS + (size_t)((l * 128 + b) * 4 + h) * 128 + tid] = nn;
#pragma unroll
        for (int t = 0; t < 4; ++t) { float pq = q[t * 128 + tid] * nv0; pq = wave_sum(pq); if (lane == 0) qn[wave * 4 + t] = pq; } }
    if (tid == 0) A.out[O_MS + (l * 128 + b) * 4 + h] = gv[21];
    __syncthreads();
    { const int t = tid >> 7, e = tid & 127; const float sit = gv[t];
      float qs = 0.f;
#pragma unroll
      for (int r2 = 0; r2 < 16; ++r2) qs += qc[(r2 * 4 + t) * 128 + e];
      float num = sit * qs;
      float dn = sit * (qn[t] + qn[4 + t]);
#pragma unroll
      for (int s2 = 0; s2 < 4; ++s2) { const float a = att[t * 4 + s2]; num += a * v[s2 * 128 + e]; dn += a; }
      HM[(size_t)(row0 + t) * 512 + h * 128 + e] = num / fmaxf(fabsf(dn), gv[4 + t]); }
    __syncthreads();
}

__device__ __forceinline__ void sgu_prompt(const Args& A, int l, LAS unsigned char* lds, int item) {
    int tid = threadIdx.x; asm volatile("" : "+v"(tid));
    const int g = item & 3, chn = item >> 2, r0 = chn * 128;
    const float* P = WSP(float, WS_P); bf16_t* MIX = WSP(bf16_t, WS_MIX);
    LAS float* vn = (LAS float*)lds;
    LAS float* Wt = vn + 128 * 128;
    const float* Wg = INL(26, 4 * 128 * 128) + (size_t)g * 128 * 128;
    __syncthreads();
    { const int s = tid >> 2, qd = tid & 3; const float* pp = P + (size_t)(r0 + s) * LDP + SG_V + g * 128 + qd * 32;
      f32x4 z[8]; float sm = 0.f;
#pragma unroll
      for (int i = 0; i < 8; ++i) { z[i] = *(const f32x4*)(pp + 4 * i);
#pragma unroll
          for (int e = 0; e < 4; ++e) { z[i][e] = gelu_erf(z[i][e]); sm += z[i][e]; } }
      sm += __shfl_xor(sm, 1); sm += __shfl_xor(sm, 2); const float mean = sm * (1.0f / 128.0f); float sq = 0.f;
#pragma unroll
      for (int i = 0; i < 8; ++i)
#pragma unroll
          for (int e = 0; e < 4; ++e) { z[i][e] -= mean; sq += z[i][e] * z[i][e]; }
      sq += __shfl_xor(sq, 1); sq += __shfl_xor(sq, 2); const float rstd = rsqrtf(sq * (1.0f / 128.0f) + EPS);
      const float* lg = INL(24, 512) + g * 128 + qd * 32; const float* lb = INL(25, 512) + g * 128 + qd * 32;
#pragma unroll
      for (int i = 0; i < 8; ++i) { const f32x4 gg = *(const f32x4*)(lg + 4 * i), bb = *(const f32x4*)(lb + 4 * i); *(LAS f32x4*)(vn + s * 128 + qd * 32 + 4 * i) = z[i] * rstd * gg + bb; } }
    for (int idx = tid; idx < 128 * 32; idx += 512) { const int t = idx & 127, s4 = (idx >> 7) * 4; const f32x4 w = *(const f32x4*)(Wg + (size_t)t * 128 + s4);
#pragma unroll
        for (int e = 0; e < 4; ++e) Wt[(s4 + e) * 128 + t] = (s4 + e <= t) ? w[e] : 0.f; }
    __syncthreads();
    const int d = tid & 127, tq = tid >> 7, t0 = tq * 32;
    float acc[32];
#pragma unroll
    for (int i = 0; i < 32; ++i) acc[i] = 0.f;
    for (int s = 0; s < t0 + 32; ++s) { const float x = vn[s * 128 + d];
#pragma unroll
        for (int i4 = 0; i4 < 8; ++i4) { const f32x4 w = *(const LAS f32x4*)(Wt + s * 128 + t0 + 4 * i4);
#pragma unroll
            for (int e = 0; e < 4; ++e) acc[i4 * 4 + e] += w[e] * x; } }
    const float* bs = INL(27, 512) + g * 128;
#pragma unroll 4
    for (int i = 0; i < 32; ++i) { const int t = t0 + i; const float u = gelu_erf(P[(size_t)(r0 + t) * LDP + SG_U + g * 128 + d]);
        MIX[(size_t)(r0 + t) * DM + 1536 + g * 128 + d] = (bf16_t)f2bf(u * (acc[i] + bs[t])); }
    __syncthreads();
}
__device__ __forceinline__ void sgu_sample(const Args& A, int l, LAS unsigned char* lds, int b) {
    int tid = threadIdx.x; asm volatile("" : "+v"(tid)); const int lane = tid & 63, wave = tid >> 6, g = tid >> 7, r0 = NPR + b * 4;
    const float* P = WSP(float, WS_P); bf16_t* MIX = WSP(bf16_t, WS_MIX);
    LAS float* ex = (LAS float*)lds;
    float z[4];
    __syncthreads();
#pragma unroll
    for (int t = 0; t < 4; ++t) { z[t] = gelu_erf(P[(size_t)(r0 + t) * LDP + SG_V + tid]); const float s = wave_sum(z[t]); if (lane == 0) ex[wave * 4 + t] = s; }
    __syncthreads();
    float mean[4];
#pragma unroll
    for (int t = 0; t < 4; ++t) mean[t] = (ex[(2 * g) * 4 + t] + ex[(2 * g + 1) * 4 + t]) * (1.0f / 128.0f);
    __syncthreads();
#pragma unroll
    for (int t = 0; t < 4; ++t) { z[t] -= mean[t]; const float s = wave_sum(z[t] * z[t]); if (lane == 0) ex[wave * 4 + t] = s; }
    __syncthreads();
    const float lg = INL(24, 512)[tid], lb = INL(25, 512)[tid];
    float vnr[4];
#pragma unroll
    for (int t = 0; t < 4; ++t) { const float var = (ex[(2 * g) * 4 + t] + ex[(2 * g + 1) * 4 + t]) * (1.0f / 128.0f); vnr[t] = z[t] * rsqrtf(var + EPS) * lg + lb;
        A.out[O_VS + ((size_t)(l * 128 + b) * 4 + t) * 512 + tid] = vnr[t]; }
    const float* Wg = INL(26, 4 * 128 * 128) + (size_t)g * 128 * 128; const float* bs = INL(27, 512) + g * 128;
#pragma unroll
    for (int t = 0; t < 4; ++t) { float mx = bs[t];
#pragma unroll
        for (int s = 0; s < 4; ++s) if (s <= t) mx += Wg[t * 128 + s] * vnr[s];
        const float u = gelu_erf(P[(size_t)(r0 + t) * LDP + SG_U + tid]);
        MIX[(size_t)(r0 + t) * DM + 1536 + tid] = (bf16_t)f2bf(u * mx); }
    __syncthreads();
}

__device__ __forceinline__ void phase_c2(const Args& A, int l, LAS unsigned char* lds) {
    const int G = gridDim.x, blk = blockIdx.x;
    constexpr int N_RP = 128, N_MP = 32, N_LONG = N_RP + N_MP;
    constexpr int N_SGP = 256, N_SGS = 128, N_MS = 512, N_RS = 1024, N_OTHER = N_SGP + N_SGS + N_MS + N_RS;
    { int it = blk;
      for (; it < N_RP; it += G) rwkv_prompt(A, l, lds, it);
      for (; it < N_LONG; it += G) mlstm_prompt(A, l, lds, (it - N_RP) >> 1, (it - N_RP) & 1); }
    unsigned* qctr = (unsigned*)(A.ws + WS_CTL + 768 * 1024) + l * 64;
    volatile LAS unsigned* tick = (volatile LAS unsigned*)(lds + 131072 + 64 + 32);
    for (;;) {
        __syncthreads();
        if (threadIdx.x == 0) tick[0] = __hip_atomic_fetch_add(qctr, 1u, __ATOMIC_RELAXED, __HIP_MEMORY_SCOPE_AGENT);
        __syncthreads();
        const int it = (int)tick[0];
        if (it >= N_OTHER) break;
        if (it < N_SGP) sgu_prompt(A, l, lds, it);
        else if (it < N_SGP + N_MS) mlstm_sample(A, l, lds, it - N_SGP);
        else if (it < N_SGP + N_MS + N_RS) rwkv_sample2(A, l, lds, it - N_SGP - N_MS);
        else sgu_sample(A, l, lds, it - N_SGP - N_MS - N_RS);
    }
}

__device__ __forceinline__ void phase_c3(const Args& A, int l) {
    int tid = threadIdx.x; asm volatile("" : "+v"(tid)); const int lane = tid & 63, wave = tid >> 6, G = gridDim.x;
    const float* P = WSP(float, WS_P); const float* HM = WSP(float, WS_HM); const float* Y = WSP(float, WS_Y); const float* AAp = WSP(float, WS_AA); const bf16_t* GG = WSP(bf16_t, WS_GG);
    bf16_t* MIX = WSP(bf16_t, WS_MIX);
    const float* mu = INL(13, RWC);
    for (int it = blockIdx.x * 8 + wave; it < TT * 5; it += G * 8) {
        const int row = it / 5, part = it - row * 5;
        const float* prow = P + (size_t)row * LDP;
        if (part == 4) {
            const int c = lane * 8;
            const f32x4 x0 = *(const f32x4*)(HM + (size_t)row * 512 + c), x1 = *(const f32x4*)(HM + (size_t)row * 512 + c + 4);
            const f32x4 o0 = *(const f32x4*)(prow + ML_O + c), o1 = *(const f32x4*)(prow + ML_O + c + 4);
            const f32x4 g0 = *(const f32x4*)(INL(12, 512) + c), g1 = *(const f32x4*)(INL(12, 512) + c + 4);
            float ss = (x0[0] * x0[0] + x0[1] * x0[1]) + (x0[2] * x0[2] + x0[3] * x0[3]) + (x1[0] * x1[0] + x1[1] * x1[1]) + (x1[2] * x1[2] + x1[3] * x1[3]);
            ss = row16_sum(ss); const float r = rsqrtf(ss * (1.0f / 128.0f) + EPS);
            u32x4 w;
            w.x = pk2(x0[0] * r * g0[0] * sigmoidf_(o0[0]), x0[1] * r * g0[1] * sigmoidf_(o0[1])); w.y = pk2(x0[2] * r * g0[2] * sigmoidf_(o0[2]), x0[3] * r * g0[3] * sigmoidf_(o0[3]));
            w.z = pk2(x1[0] * r * g1[0] * sigmoidf_(o1[0]), x1[1] * r * g1[1] * sigmoidf_(o1[1])); w.w = pk2(x1[2] * r * g1[2] * sigmoidf_(o1[2]), x1[3] * r * g1[3] * sigmoidf_(o1[3]));
            *(u32x4*)(MIX + (size_t)row * DM + c) = w;
            int shb = -1; float* dst = nullptr;
            if (row < NPR) { if ((row & (SEQ - 1)) == SEQ - 1) { shb = row >> 11; dst = A.out + O_SHP + (size_t)(l * 4 + shb) * RWC; } }
            else { const int s2 = row - NPR; if ((s2 & 3) == 3) { shb = s2 >> 2; dst = A.out + O_SHS + (size_t)(l * 128 + shb) * RWC; } }
            if (shb >= 0) for (int cc = lane * 4; cc < RWC; cc += 256) *(f32x4*)(dst + cc) = *(const f32x4*)(prow + RW0 + cc);
        } else {
            const int c = part * 256 + lane * 4;
            const f32x4 y = *(const f32x4*)(Y + (size_t)row * 1024 + c);
            const f32x4 pr = *(const f32x4*)(prow + RW_R + c), pk = *(const f32x4*)(prow + RW_K + c), pv = *(const f32x4*)(prow + RW_V + c);
            const f32x4 qr = ld_prev4(A, l, P, row, RW_R + c), qk = ld_prev4(A, l, P, row, RW_K + c), qv = ld_prev4(A, l, P, row, RW_V + c);
            const f32x4 a = *(const f32x4*)(AAp + (size_t)row * 1024 + c);
            const u32x2 ggb = *(const u32x2*)(GG + (size_t)row * 1024 + c);
            const f32x4 m_r = *(const f32x4*)(mu + (RW_R - RW0) + c), m_k = *(const f32x4*)(mu + (RW_K - RW0) + c), m_v = *(const f32x4*)(mu + (RW_V - RW0) + c);
            const f32x4 ka = *(const f32x4*)(INL(20, 1024) + c), rk = *(const f32x4*)(INL(21, 1024) + c), lg = *(const f32x4*)(INL(22, 1024) + c), lb = *(const f32x4*)(INL(23, 1024) + c);
            const float mean = row16_sum((y[0] + y[1]) + (y[2] + y[3])) * (1.0f / 64.0f);
            const f32x4 d = y - mean;
            const float var = row16_sum((d[0] * d[0] + d[1] * d[1]) + (d[2] * d[2] + d[3] * d[3])) * (1.0f / 64.0f);
            const f32x4 yn = d * rsqrtf(var + 64.0f * 1e-5f) * lg + lb;
            const f32x4 r = pr + (qr - pr) * m_r, k = pk + (qk - pk) * m_k, v = pv + (qv - pv) * m_v;
            const f32x4 k2 = k * (1.0f + (a - 1.0f) * ka);
            const f32x4 t3 = r * k2 * rk;
            const float bc = row16_sum((t3[0] + t3[1]) + (t3[2] + t3[3]));
            f32x4 gg; gg[0] = __builtin_bit_cast(float, ggb.x << 16); gg[1] = __builtin_bit_cast(float, ggb.x & 0xffff0000u); gg[2] = __builtin_bit_cast(float, ggb.y << 16); gg[3] = __builtin_bit_cast(float, ggb.y & 0xffff0000u);
            const f32x4 o = (yn + v * bc) * gg;
            u32x2 w; w.x = pk2(o[0], o[1]); w.y = pk2(o[2], o[3]);
            *(u32x2*)(MIX + (size_t)row * DM + 512 + c) = w;
        }
    }
}

__device__ __forceinline__ void ld8(const bf16_t* p, float (&o)[8]) { const u32x4 w = *(const u32x4*)p; o[0] = __builtin_bit_cast(float, w.x << 16); o[1] = __builtin_bit_cast(float, w.x & 0xffff0000u); o[2] = __builtin_bit_cast(float, w.y << 16); o[3] = __builtin_bit_cast(float, w.y & 0xffff0000u);
    o[4] = __builtin_bit_cast(float, w.z << 16); o[5] = __builtin_bit_cast(float, w.z & 0xffff0000u); o[6] = __builtin_bit_cast(float, w.w << 16); o[7] = __builtin_bit_cast(float, w.w & 0xffff0000u); }
__device__ __forceinline__ void ld8f(const float* p, float (&o)[8]) { const f32x4 a = *(const f32x4*)p, b = *(const f32x4*)(p + 4); o[0] = a[0]; o[1] = a[1]; o[2] = a[2]; o[3] = a[3]; o[4] = b[0]; o[5] = b[1]; o[6] = b[2]; o[7] = b[3]; }
__device__ __forceinline__ void st8f(float* p, const float (&o)[8]) { *(f32x4*)p = (f32x4){o[0], o[1], o[2], o[3]}; *(f32x4*)(p + 4) = (f32x4){o[4], o[5], o[6], o[7]}; }
__device__ __forceinline__ void phase_f(const Args& A, int l) {
    const int G = gridDim.x; int tid = threadIdx.x; asm volatile("" : "+v"(tid));
    const bf16_t* HUP = WSP(bf16_t, WS_HUP); bf16_t* ACT = WSP(bf16_t, WS_ACT);
    const float* cw = INL(31, 3 * DFF2); const float* cb = INL(32, DFF2);
    constexpr int NFC = DFF / 8, RSTR = 8, NSTR = TT / RSTR;
    for (int it = blockIdx.x * 512 + tid; it < NFC * NSTR; it += G * 512) {
        const int fc = it % NFC, strip = it / NFC, f = fc * 8;
        float wg[3][8], wv[3][8], bg[8], bv[8];
#pragma unroll
        for (int j = 0; j < 3; ++j) { ld8f(cw + (size_t)j * DFF2 + f, wg[j]); ld8f(cw + (size_t)j * DFF2 + DFF + f, wv[j]); }
        ld8f(cb + f, bg); ld8f(cb + DFF + f, bv);
        const int rowb = strip * RSTR;
        u32x4 cg_[RSTR], cv_[RSTR];
#pragma unroll
        for (int rr = 0; rr < RSTR; ++rr) { cg_[rr] = *(const u32x4*)(HUP + (size_t)(rowb + rr) * DFF2 + f); cv_[rr] = *(const u32x4*)(HUP + (size_t)(rowb + rr) * DFF2 + DFF + f); }
        float g0[8], g1[8], v0[8], v1[8];
        if (rowb < NPR) {
            if ((rowb & (SEQ - 1)) == 0) {
#pragma unroll
                for (int e = 0; e < 8; ++e) { g0[e] = 0.f; g1[e] = 0.f; v0[e] = 0.f; v1[e] = 0.f; } }
            else { ld8(HUP + (size_t)(rowb - 2) * DFF2 + f, g0); ld8(HUP + (size_t)(rowb - 2) * DFF2 + DFF + f, v0); ld8(HUP + (size_t)(rowb - 1) * DFF2 + f, g1); ld8(HUP + (size_t)(rowb - 1) * DFF2 + DFF + f, v1); }
        }
#pragma unroll
        for (int rr = 0; rr < RSTR; ++rr) {
            const int row = rowb + rr;
            int t, Tn, bidx; if (row < NPR) { t = row & (SEQ - 1); Tn = SEQ; bidx = row >> 11; } else { t = (row - NPR) & 3; Tn = 4; bidx = (row - NPR) >> 2; }
            if (row >= NPR && t == 0) { const float* bp = A.in[7] + ((size_t)(l * 128 + bidx) * 2) * DFF2; ld8f(bp + f, g0); ld8f(bp + DFF + f, v0); ld8f(bp + DFF2 + f, g1); ld8f(bp + DFF2 + DFF + f, v1); }
            float hg[8], hv[8];
            { const u32x4 w = cg_[rr]; hg[0] = __builtin_bit_cast(float, w.x << 16); hg[1] = __builtin_bit_cast(float, w.x & 0xffff0000u); hg[2] = __builtin_bit_cast(float, w.y << 16); hg[3] = __builtin_bit_cast(float, w.y & 0xffff0000u);
              hg[4] = __builtin_bit_cast(float, w.z << 16); hg[5] = __builtin_bit_cast(float, w.z & 0xffff0000u); hg[6] = __builtin_bit_cast(float, w.w << 16); hg[7] = __builtin_bit_cast(float, w.w & 0xffff0000u); }
            { const u32x4 w = cv_[rr]; hv[0] = __builtin_bit_cast(float, w.x << 16); hv[1] = __builtin_bit_cast(float, w.x & 0xffff0000u); hv[2] = __builtin_bit_cast(float, w.y << 16); hv[3] = __builtin_bit_cast(float, w.y & 0xffff0000u);
              hv[4] = __builtin_bit_cast(float, w.z << 16); hv[5] = __builtin_bit_cast(float, w.z & 0xffff0000u); hv[6] = __builtin_bit_cast(float, w.w << 16); hv[7] = __builtin_bit_cast(float, w.w & 0xffff0000u); }
            float o[8];
#pragma unroll
            for (int e = 0; e < 8; ++e) { const float gt = bg[e] + wg[0][e] * g0[e] + wg[1][e] * g1[e] + wg[2][e] * hg[e]; const float vl = bv[e] + wv[0][e] * v0[e] + wv[1][e] * v1[e] + wv[2][e] * hv[e];
                o[e] = gt * sigmoidf_(gt) * vl; }
            u32x4 w; w.x = pk2(o[0], o[1]); w.y = pk2(o[2], o[3]); w.z = pk2(o[4], o[5]); w.w = pk2(o[6], o[7]);
            *(u32x4*)(ACT + (size_t)row * DFF + f) = w;
            if (t >= Tn - 2) { const int jj = t - (Tn - 2);
                float* dst = (row < NPR) ? A.out + O_CBP + ((size_t)(l * 4 + bidx) * 2 + jj) * DFF2 : A.out + O_CBS + ((size_t)(l * 128 + bidx) * 2 + jj) * DFF2;
                st8f(dst + f, hg); st8f(dst + DFF + f, hv); }
#pragma unroll
            for (int e = 0; e < 8; ++e) { g0[e] = g1[e]; g1[e] = hg[e]; v0[e] = v1[e]; v1[e] = hv[e]; }
        }
    }
}

__device__ __forceinline__ void phase_r(const Args& A, int KS, float* rsn) {
    int tid = threadIdx.x; asm volatile("" : "+v"(tid)); const int lane = tid & 63, wave = tid >> 6, G = gridDim.x;
    bf16_t* XB = WSP(bf16_t, WS_XB); const float* PART = WSP(float, WS_P);
    for (int it = blockIdx.x * 8 + wave; it < NSM * 2; it += G * 8) {
        const int rl = it >> 1, hf = it & 1, row = NPR + rl; float ss = 0.f;
#pragma unroll
        for (int j = 0; j < 4; ++j) { const int c = hf * 1024 + j * 256 + lane * 4; f32x4 x = ldp4(XB + (size_t)row * DM + c);
            for (int p = 0; p < KS; ++p) x += *(const f32x4*)(PART + ((size_t)p * NSM + rl) * DM + c);
            u32x2 w; w.x = pk2(x[0], x[1]); w.y = pk2(x[2], x[3]); *(u32x2*)(XB + (size_t)row * DM + c) = w;
            ss += (x[0] * x[0] + x[1] * x[1]) + (x[2] * x[2] + x[3] * x[3]); }
        ss = wave_sum(ss);
        if (lane == 0) unsafeAtomicAdd(rsn + row, ss);
    }
}

__device__ __forceinline__ void phase_final(const Args& A) {
    int tid = threadIdx.x; asm volatile("" : "+v"(tid)); const int lane = tid & 63, wave = tid >> 6, G = gridDim.x;
    const bf16_t* XB = WSP(bf16_t, WS_XB); const float* RS = WSP(float, WS_CTL) + 4 * TT; const float* g = A.in[34];
    for (int row = blockIdx.x * 8 + wave; row < TT; row += G * 8) {
        const float s = rsqrtf(RS[row] * (1.0f / DM) + EPS);
#pragma unroll
        for (int j = 0; j < 8; ++j) { const int c = j * 256 + lane * 4; const f32x4 v = ldp4(XB + (size_t)row * DM + c); const f32x4 gg = *(const f32x4*)(g + c);
            *(f32x4*)(A.out + (size_t)row * DM + c) = v * s * gg; }
    }
}

#define XB_TMO      128
#define XB_XCNT(j)  (256  + 64 * (j))
#define XB_XSUB(j)  (1280 + 64 * (j))
#define XB_XGEN(j)  (2304 + 64 * (j))
#define XB_TOP      3328
#define XB_TOPGEN   3392
#define XCD_BAR_WORDS 3456
#define XB_SPIN_CAP (1u << 18)

__device__ __forceinline__ unsigned xb_ld(unsigned* p)              { return __hip_atomic_load(p, __ATOMIC_RELAXED, __HIP_MEMORY_SCOPE_AGENT); }
__device__ __forceinline__ unsigned xb_add(unsigned* p, unsigned v) { return __hip_atomic_fetch_add(p, v, __ATOMIC_RELAXED, __HIP_MEMORY_SCOPE_AGENT); }
__device__ __forceinline__ unsigned xb_xcc_id() { return (unsigned)__builtin_amdgcn_s_getreg((3 << 11) | 20) & 0xFu; }
#define XB_SPIN(cond, bar) do { unsigned _sp = 0; while (cond) { __builtin_amdgcn_s_sleep(1); \
    if ((++_sp & 255u) == 0u) { if (xb_ld(&(bar)[XB_TMO])) break; if (_sp > XB_SPIN_CAP) { atomicAdd(&(bar)[XB_TMO], 1u); break; } } } } while (0)

struct XcdBarrier {
    unsigned* bar; unsigned x;
    volatile LAS unsigned* st;
};

__device__ __forceinline__ XcdBarrier xcd_barrier_post(unsigned* bar, volatile LAS unsigned* st) {
    XcdBarrier b; b.bar = bar; b.x = xb_xcc_id(); b.st = st;
    if (threadIdx.x == 0) (void)xb_add(&bar[XB_XCNT(b.x)], 1u);
    return b;
}
__device__ __forceinline__ void xcd_barrier_complete(unsigned* bar, unsigned x, unsigned& nloc, unsigned& nx) {
    const unsigned G = gridDim.x * gridDim.y * gridDim.z;
    unsigned sum, cnt, mine, sp = 0u;
    for (;;) {
        sum = 0u; cnt = 0u; mine = 0u;
#pragma unroll
        for (unsigned j = 0; j < 16; ++j) { const unsigned c = xb_ld(&bar[XB_XCNT(j)]); sum += c; cnt += (c > 0u) ? 1u : 0u; mine = (j == x) ? c : mine; }
        if (sum == G) break;
        __builtin_amdgcn_s_sleep(1);
        if ((++sp & 255u) == 0u) { if (xb_ld(&bar[XB_TMO])) break; if (sp > XB_SPIN_CAP) { atomicAdd(&bar[XB_TMO], 1u); break; } }
    }
    nloc = mine > 0u ? mine : 1u; nx = cnt > 0u ? cnt : 1u;
}

__device__ __forceinline__ void xcd_barrier(const XcdBarrier& b) {
    asm volatile("s_waitcnt vmcnt(0)" ::: "memory");
    __syncthreads();
    if (threadIdx.x == 0) {
        unsigned* bar = b.bar;
        __builtin_amdgcn_s_waitcnt(0);
        unsigned nloc = b.st[0], nx = b.st[1];
        if (nloc == 0u) { xcd_barrier_complete(bar, b.x, nloc, nx); b.st[0] = nloc; b.st[1] = nx; }
        const unsigned old = xb_add(&bar[XB_XSUB(b.x)], 1u);
        const unsigned gen = old / nloc;
        if (old + 1u == (gen + 1u) * nloc) {
            __builtin_amdgcn_fence(__ATOMIC_RELEASE, "agent");
            asm volatile("s_waitcnt vmcnt(0)" ::: "memory");
            const unsigned og = xb_add(&bar[XB_TOP], 1u);
            const unsigned tg = og / nx;
            if (og + 1u == (tg + 1u) * nx) xb_add(&bar[XB_TOPGEN], 1u);
            else XB_SPIN(xb_ld(&bar[XB_TOPGEN]) == tg, bar);
            __builtin_amdgcn_fence(__ATOMIC_ACQUIRE, "agent");
            xb_add(&bar[XB_XGEN(b.x)], 1u);
            asm volatile("s_waitcnt vmcnt(0)" ::: "memory");
        } else {
            XB_SPIN(xb_ld(&bar[XB_XGEN(b.x)]) == gen, bar);
            __builtin_amdgcn_fence(__ATOMIC_ACQUIRE, "agent");
            asm volatile("s_waitcnt vmcnt(0)" ::: "memory");
        }
    }
    __syncthreads();
}

constexpr int N_SUB = 10, N_PHASES = 2 + 2 * N_SUB;
constexpr int KS_D = 8, KS_G = 11;
__global__ void __launch_bounds__(512, 2) fwd(Args A0) {
    extern __shared__ __attribute__((aligned(16))) unsigned char lds_raw[];
    LAS unsigned char* lds = (LAS unsigned char*)lds_raw;
    cg::grid_group grid = cg::this_grid();
    const int G = gridDim.x;
    volatile LAS unsigned* MISC = (volatile LAS unsigned*)(lds + 131072 + 64);
    if (threadIdx.x < 4) MISC[threadIdx.x] = 0u;
    __syncthreads();
    XcdBarrier xbar = xcd_barrier_post((unsigned*)(A0.ws + WS_CTL + 512 * 1024), MISC);
    bool first_seam = true;
    for (int ph = A0.ph_lo; ph < A0.ph_hi; ++ph) {
        const int l = (ph - 1) / N_SUB, sub = (ph - 1) % N_SUB;
        const int dupbit = (ph == 0) ? 0 : (ph == N_PHASES - 1) ? 1 : 2 + sub;
        const int reps = 1 + ((DUP_MASK >> dupbit) & 1);
        for (int rep = 0; rep < reps; ++rep) {
        if (ph > A0.ph_lo || rep > 0) { if (first_seam) { grid.sync(); first_seam = false; } else xcd_barrier(xbar); }
        Args B = A0; { size_t z = 0; asm volatile("s_mov_b64 %0, 0" : "=s"(z)); B.ws = A0.ws + z; B.out = A0.out + z; } const Args& A = B;
        if (ph == 0) { phase_prologue(A, lds); continue; }
        if (ph == N_PHASES - 1) { phase_final(A); continue; }
        float* RS = WSP(float, WS_CTL);
        switch (sub) {
        case 0: { pg8::Gemm g{WSP(bf16_t, WS_XB), WSP(bf16_t, WS_WIN) + (size_t)l * LDP * DM, TT, LDP, DM, DM, DM}; pg8::StaticOrder S; S.init(TT, LDP, G, (int)blockIdx.x);
                  pg8::EpiP E{WSP(float, WS_P), LDP, RS + (size_t)(2 * l) * TT}; pg8::gemm_phase<pg8::EpiP, pg8::StaticOrder>(lds, g, S, E); } break;
        case 1: phase_c1(A, l, lds); break;
        case 2: phase_c2(A, l, lds); break;
        case 3: phase_c3(A, l); break;
        case 4: { { pg8::Gemm g{WSP(bf16_t, WS_MIX), WSP(bf16_t, WS_WOUT) + (size_t)l * DM * DM, NPR, DM, DM, DM, DM}; pg8::StaticOrder S; S.init(NPR, DM, G, (int)blockIdx.x);
                    pg8::EpiRes E{WSP(bf16_t, WS_XB), RS + (size_t)(2 * l + 1) * TT}; pg8::gemm_phase<pg8::EpiRes, pg8::StaticOrder>(lds, g, S, E); }
                  { pg8::Gemm g{WSP(bf16_t, WS_MIX) + (size_t)NPR * DM, WSP(bf16_t, WS_WOUT) + (size_t)l * DM * DM, NSM, DM, DM / KS_D, DM, DM}; pg8::SplitOrder S; S.init(NSM, DM, KS_D, G, (int)((blockIdx.x + 128) % G));
                    pg8::EpiPart E{WSP(float, WS_P), NSM}; pg8::gemm_phase<pg8::EpiPart, pg8::SplitOrder>(lds, g, S, E); } } break;
        case 5: phase_r(A, KS_D, RS + (size_t)(2 * l + 1) * TT); break;
        case 6: { pg8::Gemm g{WSP(bf16_t, WS_XB), WSP(bf16_t, WS_WUP) + (size_t)l * DFF2 * DM, TT, DFF2, DM, DM, DM}; pg8::StaticOrder S; S.init(TT, DFF2, G, (int)blockIdx.x);
                  pg8::EpiUp E{WSP(bf16_t, WS_HUP), DFF2, RS + (size_t)(2 * l + 1) * TT}; pg8::gemm_phase<pg8::EpiUp, pg8::StaticOrder>(lds, g, S, E); } break;
        case 7: phase_f(A, l); break;
        case 8: { { pg8::Gemm g{WSP(bf16_t, WS_ACT), WSP(bf16_t, WS_WDN) + (size_t)l * DM * DFF, NPR, DM, DFF, DFF, DFF}; pg8::StaticOrder S; S.init(NPR, DM, G, (int)blockIdx.x);
                    pg8::EpiRes E{WSP(bf16_t, WS_XB), RS + (size_t)(2 * l + 2) * TT}; pg8::gemm_phase<pg8::EpiRes, pg8::StaticOrder>(lds, g, S, E); }
                  { pg8::Gemm g{WSP(bf16_t, WS_ACT) + (size_t)NPR * DFF, WSP(bf16_t, WS_WDN) + (size_t)l * DM * DFF, NSM, DM, DFF / KS_G, DFF, DFF}; pg8::SplitOrder S; S.init(NSM, DM, KS_G, G, (int)((blockIdx.x + 128) % G));
                    pg8::EpiPart E{WSP(float, WS_P), NSM}; pg8::gemm_phase<pg8::EpiPart, pg8::SplitOrder>(lds, g, S, E); } } break;
        case 9: phase_r(A, KS_G, RS + (size_t)(2 * l + 2) * TT); break;
        }
        }
    }
}

extern "C" void kernel_launch(void* const* d_in, const int* in_sizes, int n_in, void* d_out, int out_size, void* d_ws, size_t ws_size, hipStream_t stream) {
    static int grid = 0;
    if (grid == 0) {
        if (n_in != 35 || (size_t)out_size != O_END || ws_size < WS_END) { fprintf(stderr, "kernel_launch: unexpected sizes n_in %d out %d ws %zu (need %zu)\n", n_in, out_size, ws_size, (size_t)WS_END); grid = -1; return; }
        if (hipFuncSetAttribute((const void*)fwd, hipFuncAttributeMaxDynamicSharedMemorySize, LDS_BYTES) != hipSuccess) { fprintf(stderr, "kernel_launch: hipFuncSetAttribute failed\n"); grid = -1; return; }
        int dev = 0, cus = 0, per_cu = 0;
        hipGetDevice(&dev); hipDeviceGetAttribute(&cus, hipDeviceAttributeMultiprocessorCount, dev);
        if (hipOccupancyMaxActiveBlocksPerMultiprocessor(&per_cu, (const void*)fwd, 512, LDS_BYTES) != hipSuccess || per_cu < 1) { fprintf(stderr, "kernel_launch: occupancy query failed (%d)\n", per_cu); per_cu = 1; }
        (void)hipGetLastError();
        grid = cus * per_cu;
        fprintf(stderr, "kernel_launch: grid %d (cus %d x %d)\n", grid, cus, per_cu);
    }
    if (grid < 0) return;
    (void)hipMemsetAsync((char*)d_ws + WS_CTL, 0, CTL_BYTES, stream);
    Args a{};
    for (int i = 0; i < 35; ++i) a.in[i] = (const float*)d_in[i];
    a.out = (float*)d_out; a.ws = (unsigned char*)d_ws;
#if MK_ONE_LAUNCH
    a.ph_lo = 0; a.ph_hi = N_PHASES;
    void* args[] = {&a};
    hipError_t e = hipLaunchCooperativeKernel((const void*)fwd, dim3(grid), dim3(512), args, LDS_BYTES, stream);
    if (e != hipSuccess) fprintf(stderr, "kernel_launch: cooperative launch failed: %s (grid %d)\n", hipGetErrorString(e), grid);
#else
    for (int ph = 0; ph < N_PHASES; ++ph) { a.ph_lo = ph; a.ph_hi = ph + 1; hipLaunchKernelGGL(fwd, dim3(grid), dim3(512), LDS_BYTES, stream, a); }
#endif
}
```

```cpp
#include <hip/hip_runtime.h>
#include <hip/hip_cooperative_groups.h>
#include <cstdio>
#include <cstdint>
namespace cg = cooperative_groups;

#ifndef C2_MASK
#define C2_MASK 0xFF
#endif
#ifndef DUP_MASK
#define DUP_MASK 0
#endif
#ifndef MK_ONE_LAUNCH
#define MK_ONE_LAUNCH 1
#endif

#define LAS __attribute__((address_space(3)))
typedef unsigned short bf16_t;
typedef short bf16x8 __attribute__((ext_vector_type(8)));
typedef float f32x4 __attribute__((ext_vector_type(4)));
typedef float f32x2 __attribute__((ext_vector_type(2)));
typedef unsigned u32x4 __attribute__((ext_vector_type(4)));
typedef unsigned u32x2 __attribute__((ext_vector_type(2)));

constexpr int DM = 2048, NPR = 8192, NSM = 512, TT = 8704, SEQ = 2048, DEPTH = 2;
constexpr int NIN = 6408, LDP = 6656, DFF = 5632, DFF2 = 11264;
constexpr int ML_Q = 0, ML_K = 512, ML_V = 1024, ML_O = 1536, ML_IG = 2048, ML_FG = 2052;
constexpr int RW0 = 2056, RW_R = 2056, RW_K = 3080, RW_V = 4104, RW_LW = 5128, RW_LA = 5192, RW_LG = 5256, RWC = 3328;
constexpr int SG_U = 5384, SG_V = 5896;
constexpr float EPS = 1e-6f;

constexpr size_t O_YP = 0;
constexpr size_t O_YS = O_YP + (size_t)4 * 2048 * 2048;
constexpr size_t O_CP = O_YS + (size_t)128 * 4 * 2048;
constexpr size_t O_NP = O_CP + (size_t)2 * 4 * 4 * 128 * 128;
constexpr size_t O_MP = O_NP + (size_t)2 * 4 * 4 * 128;
constexpr size_t O_SP = O_MP + (size_t)2 * 4 * 4;
constexpr size_t O_SHP = O_SP + (size_t)2 * 4 * 16 * 64 * 64;
constexpr size_t O_CBP = O_SHP + (size_t)2 * 4 * 3328;
constexpr size_t O_CS = O_CBP + (size_t)2 * 4 * 2 * 11264;
constexpr size_t O_NS = O_CS + (size_t)2 * 128 * 4 * 128 * 128;
constexpr size_t O_MS = O_NS + (size_t)2 * 128 * 4 * 128;
constexpr size_t O_SS = O_MS + (size_t)2 * 128 * 4;
constexpr size_t O_SHS = O_SS + (size_t)2 * 128 * 16 * 64 * 64;
constexpr size_t O_CBS = O_SHS + (size_t)2 * 128 * 3328;
constexpr size_t O_VS = O_CBS + (size_t)2 * 128 * 2 * 11264;
constexpr size_t O_END = O_VS + (size_t)2 * 128 * 4 * 512;

constexpr size_t MiB = 1u << 20;
constexpr size_t WS_CTL = 0, CTL_BYTES = 1 * MiB;
constexpr size_t WS_WIN = 1 * MiB;
constexpr size_t WS_WOUT = WS_WIN + 52 * MiB;
constexpr size_t WS_WUP = WS_WOUT + 16 * MiB;
constexpr size_t WS_WDN = WS_WUP + 88 * MiB;
constexpr size_t WS_X = WS_WDN + 44 * MiB;
constexpr size_t WS_XB = WS_X + 68 * MiB;
constexpr size_t WS_MIX = WS_XB + 34 * MiB;
constexpr size_t WS_P = WS_MIX + 34 * MiB;
constexpr size_t WS_ACT = WS_P + 221 * MiB;
constexpr size_t WS_HUP = WS_P;
constexpr size_t WS_Y = WS_X;
constexpr size_t WS_DEC = WS_ACT;
constexpr size_t WS_AA = WS_DEC + 34 * MiB;
constexpr size_t WS_KKN = WS_AA + 34 * MiB;
constexpr size_t WS_GG = WS_KKN + 34 * MiB;
constexpr size_t WS_HM = WS_GG + 17 * MiB;
constexpr size_t WS_GATE = WS_HM + 17 * MiB;
constexpr size_t WS_BC = WS_GATE + 1 * MiB;
constexpr size_t WS_END = WS_BC + 1 * MiB;

constexpr int LDS_BYTES = 147456;

struct Args { const float* in[35]; float* out; unsigned char* ws; int ph_lo, ph_hi; };

__device__ __forceinline__ unsigned f2bf(float f) { unsigned u = __builtin_bit_cast(unsigned, f); return (u + 0x7fffu + ((u >> 16) & 1u)) >> 16; }
__device__ __forceinline__ unsigned pk2(float lo, float hi) { return f2bf(lo) | (f2bf(hi) << 16); }
__device__ __forceinline__ float bf2f(unsigned short b) { return __builtin_bit_cast(float, ((unsigned)b) << 16); }
__device__ __forceinline__ f32x4 ldp4(const bf16_t* p) { const u32x2 w = *(const u32x2*)p; f32x4 r; r[0] = __builtin_bit_cast(float, w.x << 16); r[1] = __builtin_bit_cast(float, w.x & 0xffff0000u); r[2] = __builtin_bit_cast(float, w.y << 16); r[3] = __builtin_bit_cast(float, w.y & 0xffff0000u); return r; }
__device__ __forceinline__ unsigned cvt_pk_bf16(float lo, float hi) { unsigned r; asm volatile("v_cvt_pk_bf16_f32 %0, %1, %2" : "=v"(r) : "v"(lo), "v"(hi)); return r; }
template <int CTRL> __device__ __forceinline__ float dpp_f(float x) { return __builtin_bit_cast(float, __builtin_amdgcn_update_dpp(0, __builtin_bit_cast(int, x), CTRL, 0xf, 0xf, false)); }
__device__ __forceinline__ float row16_sum(float x) { x += dpp_f<0x128>(x); x += dpp_f<0x124>(x); x += dpp_f<0x122>(x); x += dpp_f<0x121>(x); return x; }
__device__ __forceinline__ float rlane(float x, int l) { return __builtin_bit_cast(float, __builtin_amdgcn_readlane(__builtin_bit_cast(int, x), l)); }
__device__ __forceinline__ float wave_sum(float x) { x = row16_sum(x); return (rlane(x, 0) + rlane(x, 16)) + (rlane(x, 32) + rlane(x, 48)); }
__device__ __forceinline__ float sigmoidf_(float x) { return 1.0f / (1.0f + __expf(-x)); }
__device__ __forceinline__ float gelu_erf(float v) {
    const float av = fabsf(v), t = __builtin_amdgcn_rcpf(av * 0.2316418882f + 1.0f);
    float q = t * 0.5307027145f + (-0.7265760135f); q = q * t + 0.7107068705f; q = q * t + (-0.142248368f); q = q * t + 0.127414796f; q = q * t;
    const float e = __builtin_amdgcn_exp2f((v * v) * (-0.72134752044f));
    const float m = v * (q * e), r = v - m; return v < 0.f ? m : r; }
__device__ __forceinline__ float log1pexp_negabs(float x) { return __logf(1.0f + __expf(-fabsf(x))); }

namespace pg8 {
constexpr int BM = 256, BK = 64, HALF = 128, HTB = HALF * BK * 2, STAGE_BYTES = 8 * HTB, NXCD = 8, WGM = 8;
__host__ __device__ __forceinline__ int lds_byte(int r, int c) { const int st = (r >> 4) * 2 + (c >> 5), rr = r & 15, cc = c & 31, ob = rr * 64 + cc * 2; return st * 1024 + (ob ^ (((ob >> 9) & 1) << 5)); }
__host__ __device__ __forceinline__ void stage_rc(int b, int& R, int& C) { const int st = b / 1024, sb = b % 1024, swz = sb ^ (((sb >> 9) & 1) << 5); R = (st >> 1) * 16 + swz / 64; C = (st & 1) * 32 + (swz % 64) / 2; }
__host__ __device__ __forceinline__ int perm32(int rho) { const int n = rho >> 4, i = rho & 15; return 8 * (i >> 2) + 4 * n + (i & 3); }
struct Unit { int pm, pn, pk; };
struct Gemm { const bf16_t* A; const bf16_t* Bt; int M, N, K, lda, ldb; };
struct StaticOrder {
    int nM, nN, nwg, G, c;
    __device__ void init(int M, int N, int G_, int c_) { nM = M / BM; nN = N / BM; nwg = nM * nN; G = G_; c = c_; }
    __device__ bool next(int i, Unit& u) const {
        const long L = (long)i * G + c; if (L >= nwg) return false;
        int wgid = (int)L; { const int q = nwg / NXCD, r = nwg % NXCD, xcd = wgid % NXCD, off = wgid / NXCD; wgid = (xcd < r ? xcd * (q + 1) : r * (q + 1) + (xcd - r) * q) + off; }
        const int nig = WGM * nN, gid = wgid / nig, fm = gid * WGM, gsz = (nM - fm) < WGM ? (nM - fm) : WGM;
        u.pm = fm + ((wgid % nig) % gsz); u.pn = (wgid % nig) / gsz; u.pk = 0; return true;
    }
};
struct SplitOrder {
    int nM, nN, KS, G, c;
    __device__ void init(int M, int N, int KS_, int G_, int c_) { nM = M / BM; nN = N / BM; KS = KS_; G = G_; c = c_; }
    __device__ bool next(int i, Unit& u) const {
        const int L = i * G + c; if (L >= nM * nN * KS) return false;
        u.pk = L % KS; const int r = L / KS; u.pn = r % nN; u.pm = r / nN; return true;
    }
};
struct EpiP {
    static constexpr bool PERM = false;
    float* C; int ldc; const float* rs;
    __device__ __forceinline__ void operator()(const f32x4 (&acc)[2][2][4][2], const Unit& u, int wr, int wc, int fr, int fq) const {
        const int row0 = u.pm * BM + wr * 64 + fr, col0 = u.pn * BM + wc * 32 + 4 * fq;
#pragma unroll
        for (int ai = 0; ai < 2; ++ai)
#pragma unroll
            for (int m = 0; m < 4; ++m) { const int row = row0 + ai * HALF + m * 16; const float s = rsqrtf(rs[row] * (1.0f / DM) + EPS); float* rowp = C + (size_t)row * ldc + col0;
#pragma unroll
                for (int bj = 0; bj < 2; ++bj)
#pragma unroll
                    for (int n = 0; n < 2; ++n) *(f32x4*)(rowp + bj * HALF + n * 16) = acc[ai][bj][m][n] * s; }
    }
};
struct EpiPart {
    static constexpr bool PERM = false;
    float* C; int mloc;
    __device__ __forceinline__ void operator()(const f32x4 (&acc)[2][2][4][2], const Unit& u, int wr, int wc, int fr, int fq) const {
        const int row0 = u.pm * BM + wr * 64 + fr, col0 = u.pn * BM + wc * 32 + 4 * fq;
#pragma unroll
        for (int ai = 0; ai < 2; ++ai)
#pragma unroll
            for (int m = 0; m < 4; ++m) { const int row = row0 + ai * HALF + m * 16; float* rowp = C + ((size_t)u.pk * mloc + row) * DM + col0;
#pragma unroll
                for (int bj = 0; bj < 2; ++bj)
#pragma unroll
                    for (int n = 0; n < 2; ++n) *(f32x4*)(rowp + bj * HALF + n * 16) = acc[ai][bj][m][n]; }
    }
};
struct EpiUp {
    static constexpr bool PERM = true;
    bf16_t* O; int ldc; const float* rs;
    __device__ __forceinline__ void operator()(const f32x4 (&acc)[2][2][4][2], const Unit& u, int wr, int wc, int fr, int fq) const {
        const int row0 = u.pm * BM + wr * 64 + fr, col0 = u.pn * BM + wc * 32 + 8 * fq;
#pragma unroll
        for (int ai = 0; ai < 2; ++ai)
#pragma unroll
            for (int m = 0; m < 4; ++m) { const int row = row0 + ai * HALF + m * 16; const float s = rsqrtf(rs[row] * (1.0f / DM) + EPS); bf16_t* rowp = O + (size_t)row * ldc + col0;
#pragma unroll
                for (int bj = 0; bj < 2; ++bj) { const f32x4 v0 = acc[ai][bj][m][0] * s, v1 = acc[ai][bj][m][1] * s;
                    u32x4 w; w.x = cvt_pk_bf16(v0[0], v0[1]); w.y = cvt_pk_bf16(v0[2], v0[3]); w.z = cvt_pk_bf16(v1[0], v1[1]); w.w = cvt_pk_bf16(v1[2], v1[3]);
                    *(u32x4*)(rowp + bj * HALF) = w; } }
    }
};
struct EpiRes {
    static constexpr bool PERM = false;
    bf16_t* XB; float* rsn;
    __device__ __forceinline__ void operator()(const f32x4 (&acc)[2][2][4][2], const Unit& u, int wr, int wc, int fr, int fq) const {
        const int row0 = u.pm * BM + wr * 64 + fr, col0 = u.pn * BM + wc * 32 + 4 * fq;
#pragma unroll
        for (int ai = 0; ai < 2; ++ai)
#pragma unroll
            for (int m = 0; m < 4; ++m) { const int row = row0 + ai * HALF + m * 16; bf16_t* rowb = XB + (size_t)row * DM + col0; float ss = 0.f;
#pragma unroll
                for (int bj = 0; bj < 2; ++bj)
#pragma unroll
                    for (int n = 0; n < 2; ++n) { f32x4 x = ldp4(rowb + bj * HALF + n * 16) + acc[ai][bj][m][n];
                        u32x2 w; w.x = cvt_pk_bf16(x[0], x[1]); w.y = cvt_pk_bf16(x[2], x[3]); *(u32x2*)(rowb + bj * HALF + n * 16) = w;
                        ss += (x[0] * x[0] + x[1] * x[1]) + (x[2] * x[2] + x[3] * x[3]); }
                ss += __shfl_xor(ss, 16); ss += __shfl_xor(ss, 32);
                if (fq == 0) unsafeAtomicAdd(rsn + row, ss); }
    }
};

template <class Epi, class Sched>
__device__ __forceinline__ void gemm_phase(LAS unsigned char* lds, const Gemm g, const Sched& S, const Epi& E) {
    int tid = threadIdx.x; asm volatile("" : "+v"(tid)); const int wid = __builtin_amdgcn_readfirstlane(tid >> 6), lane = tid & 63, wr = wid >> 2, wc = wid & 3, fr = lane & 15, fq = lane >> 4;
    const int K = g.K, nt = K / BK;
    unsigned voffA[2], voffB[2];
#pragma unroll
    for (int i = 0; i < 2; ++i) { int R, C; stage_rc(tid * 16 + i * 8192, R, C); const int Rb = Epi::PERM ? ((R & ~31) + perm32(R & 31)) : R;
        voffA[i] = (unsigned)(R * g.lda + C) * 2u; voffB[i] = (unsigned)(Rb * g.ldb + C) * 2u; }
    const size_t kstep = (size_t)(BK * 2);
    const size_t hstepA = (size_t)HALF * g.lda * 2, hstepB = (size_t)HALF * g.ldb * 2;
    const size_t tstepA = 2 * hstepA, tstepB = 2 * hstepB, kofs = (size_t)K * 2;
    const unsigned ldsw = (unsigned)wid * 1024u;
    const int aoff = lds_byte(wr * 64 + fr, fq * 8), boff = lds_byte(wc * 32 + fr, fq * 8);
#define PG8_SA(b, h) (((b) * 2 + (h)) * HTB)
#define PG8_SB(b, h) ((4 + (b) * 2 + (h)) * HTB)
#define PG8_STAGE(bufoff, gbase, voff) do { _Pragma("unroll") for (int _i = 0; _i < 2; ++_i) \
        __builtin_amdgcn_global_load_lds((const unsigned*)((const char*)(gbase) + (voff)[_i]), (LAS unsigned*)(lds + (bufoff) + ldsw + _i * 8192), 16, 0, 0); } while (0)
#define PG8_LDA(dst, b, h) do { _Pragma("unroll") for (int m = 0; m < 4; ++m) _Pragma("unroll") for (int k = 0; k < 2; ++k) dst[m][k] = *(const LAS bf16x8*)(lds + PG8_SA(b, h) + aoff + m * 2048 + k * 1024); } while (0)
#define PG8_LDB(dst, b, h) do { _Pragma("unroll") for (int n = 0; n < 2; ++n) _Pragma("unroll") for (int k = 0; k < 2; ++k) dst[n][k] = *(const LAS bf16x8*)(lds + PG8_SB(b, h) + boff + n * 2048 + k * 1024); } while (0)
#define PG8_MMA(ai, bj, At, Bt) do { __builtin_amdgcn_s_setprio(1); _Pragma("unroll") for (int m = 0; m < 4; ++m) _Pragma("unroll") for (int n = 0; n < 2; ++n) _Pragma("unroll") for (int k = 0; k < 2; ++k) \
        acc[ai][bj][m][n] = __builtin_amdgcn_mfma_f32_16x16x32_bf16(Bt[n][k], At[m][k], acc[ai][bj][m][n], 0, 0, 0); __builtin_amdgcn_s_setprio(0); } while (0)
#define PG8_WAIT_V(n) asm volatile("s_waitcnt vmcnt(" #n ")" ::: "memory")
#define PG8_WAIT_L(n) asm volatile("s_waitcnt lgkmcnt(" #n ")" ::: "memory")
#define PG8_BAR __builtin_amdgcn_s_barrier()
#define PG8_SCHED __builtin_amdgcn_sched_barrier(0)
    Unit cur, nxt; int ui = 0;
    if (!S.next(0, cur)) return;
    f32x4 acc[2][2][4][2];
#pragma unroll
    for (int a = 0; a < 2; ++a)
#pragma unroll
        for (int b = 0; b < 2; ++b)
#pragma unroll
            for (int m = 0; m < 4; ++m)
#pragma unroll
                for (int n = 0; n < 2; ++n) acc[a][b][m][n] = (f32x4){0.f, 0.f, 0.f, 0.f};
    bf16x8 At[4][2], B0[2][2], B1[2][2];
    const char* cA = (const char*)g.A + (size_t)cur.pm * tstepA + (size_t)cur.pk * kofs; const char* cB = (const char*)g.Bt + (size_t)cur.pn * tstepB + (size_t)cur.pk * kofs;
    PG8_STAGE(PG8_SB(0, 0), cB, voffB); PG8_STAGE(PG8_SB(0, 1), cB + hstepB, voffB); PG8_STAGE(PG8_SA(0, 0), cA, voffA); PG8_STAGE(PG8_SA(0, 1), cA + hstepA, voffA);
    if (wr == 1) PG8_BAR;
    PG8_WAIT_V(2); PG8_BAR;
    PG8_STAGE(PG8_SB(1, 0), cB + kstep, voffB); PG8_STAGE(PG8_SA(1, 0), cA + kstep, voffA); PG8_STAGE(PG8_SB(1, 1), cB + hstepB + kstep, voffB);
    PG8_WAIT_V(6); PG8_BAR;
    for (;;) {
        const bool has_next = S.next(ui + 1, nxt);
        const char* nA = has_next ? (const char*)g.A + (size_t)nxt.pm * tstepA + (size_t)nxt.pk * kofs : cA; const char* nB = has_next ? (const char*)g.Bt + (size_t)nxt.pn * tstepB + (size_t)nxt.pk * kofs : cB;
        for (int t = 0; t < nt; t += 2) {
            const bool last = (t == nt - 2);
            const char* a1 = cA + (size_t)(t + 1) * kstep;
            const char* a2 = last ? nA : cA + (size_t)(t + 2) * kstep; const char* b2 = last ? nB : cB + (size_t)(t + 2) * kstep;
            const char* a3 = a2 + kstep; const char* b3 = b2 + kstep;
            PG8_LDB(B0, 0, 0); PG8_LDB(B1, 0, 1); PG8_SCHED; PG8_LDA(At, 0, 0); PG8_STAGE(PG8_SA(1, 1), a1 + hstepA, voffA);
            PG8_WAIT_V(8); PG8_WAIT_L(0); PG8_BAR; PG8_MMA(0, 0, At, B0); PG8_MMA(0, 1, At, B1); PG8_BAR; PG8_SCHED;
            PG8_LDA(At, 0, 1); PG8_STAGE(PG8_SB(0, 0), b2, voffB); PG8_STAGE(PG8_SB(0, 1), b2 + hstepB, voffB); PG8_STAGE(PG8_SA(0, 0), a2, voffA);
            PG8_WAIT_V(8); PG8_WAIT_L(0); PG8_BAR; PG8_MMA(1, 0, At, B0); PG8_MMA(1, 1, At, B1); PG8_BAR; PG8_SCHED;
            PG8_LDB(B0, 1, 0); PG8_LDB(B1, 1, 1); PG8_SCHED; PG8_LDA(At, 1, 0); PG8_STAGE(PG8_SA(0, 1), a2 + hstepA, voffA);
            PG8_WAIT_V(8); PG8_WAIT_L(0); PG8_BAR; PG8_MMA(0, 0, At, B0); PG8_MMA(0, 1, At, B1); PG8_BAR; PG8_SCHED;
            PG8_LDA(At, 1, 1); PG8_STAGE(PG8_SB(1, 0), b3, voffB); PG8_STAGE(PG8_SB(1, 1), b3 + hstepB, voffB); PG8_STAGE(PG8_SA(1, 0), a3, voffA);
            PG8_WAIT_V(8); PG8_WAIT_L(0); PG8_BAR; PG8_MMA(1, 0, At, B0); PG8_MMA(1, 1, At, B1); PG8_BAR; PG8_SCHED;
        }
        if (wr == 0) PG8_BAR;
        E(acc, cur, wr, wc, fr, fq);
        if (!has_next) break;
#pragma unroll
        for (int a = 0; a < 2; ++a)
#pragma unroll
            for (int b = 0; b < 2; ++b)
#pragma unroll
                for (int m = 0; m < 4; ++m)
#pragma unroll
                    for (int n = 0; n < 2; ++n) acc[a][b][m][n] = (f32x4){0.f, 0.f, 0.f, 0.f};
        cur = nxt; cA = nA; cB = nB; ++ui;
        if (wr == 1) PG8_BAR;
    }
    PG8_WAIT_V(0);
    PG8_BAR;
#undef PG8_SA
#undef PG8_SB
#undef PG8_STAGE
#undef PG8_LDA
#undef PG8_LDB
#undef PG8_MMA
#undef PG8_WAIT_V
#undef PG8_WAIT_L
#undef PG8_BAR
#undef PG8_SCHED
}
}

struct Ptrs {
    const Args* a; int l;
};
#define WSP(T, off) ((T*)(A.ws + (off)))
#define INL(i, per) (A.in[i] + (size_t)l * (per))

__device__ __forceinline__ void transpose_item(const float* W, int K, int N, int Npad, bf16_t* WT, const float* gsc, LAS float* scr, int item, int lane) {
    const int nblk = Npad / 32, kb = item / nblk, nb = item % nblk, k0 = 64 * kb, n0 = 32 * nb;
    const int n = n0 + (lane & 31);
    float tv[32];
#pragma unroll
    for (int i = 0; i < 32; ++i) { const int kk = 2 * i + (lane >> 5); tv[i] = (n < N) ? W[(size_t)(k0 + kk) * N + n] : 0.f; }
#pragma unroll
    for (int i = 0; i < 32; ++i) { const int kk = 2 * i + (lane >> 5); float v = tv[i]; if (gsc) v *= gsc[k0 + kk]; scr[kk * 33 + (lane & 31)] = v; }
    asm volatile("s_waitcnt lgkmcnt(0)" ::: "memory");
    const int c = lane & 7;
#pragma unroll
    for (int j = 0; j < 4; ++j) { const int nn = (lane >> 3) + 8 * j; const LAS float* s = scr + (8 * c) * 33 + nn;
        u32x4 o; o.x = pk2(s[0 * 33], s[1 * 33]); o.y = pk2(s[2 * 33], s[3 * 33]); o.z = pk2(s[4 * 33], s[5 * 33]); o.w = pk2(s[6 * 33], s[7 * 33]);
        *(u32x4*)(WT + (size_t)(n0 + nn) * K + k0 + 8 * c) = o; }
    asm volatile("s_waitcnt lgkmcnt(0)" ::: "memory");
}
__device__ __forceinline__ void phase_prologue(const Args& A, LAS unsigned char* lds) {
    int tid = threadIdx.x; asm volatile("" : "+v"(tid)); const int lane = tid & 63, wave = __builtin_amdgcn_readfirstlane(tid >> 6), G = gridDim.x;
    LAS float* scr = (LAS float*)(lds + wave * 16384);
    const int gw = blockIdx.x * 8 + wave, NGW = G * 8;
    constexpr int I_IN = 32 * 208, I_OUT = 32 * 64, I_UP = 32 * 352, I_DN = 88 * 64, I_L = I_IN + I_OUT + I_UP + I_DN;
    for (int it = gw; it < 2 * I_L; it += NGW) {
        const int l = it / I_L; int r = it % I_L;
        if (r < I_IN) { transpose_item(INL(9, (size_t)DM * NIN), DM, NIN, LDP, WSP(bf16_t, WS_WIN) + (size_t)l * LDP * DM, INL(8, DM), scr, r, lane); continue; } r -= I_IN;
        if (r < I_OUT) { transpose_item(INL(28, (size_t)DM * DM), DM, DM, DM, WSP(bf16_t, WS_WOUT) + (size_t)l * DM * DM, nullptr, scr, r, lane); continue; } r -= I_OUT;
        if (r < I_UP) { transpose_item(INL(30, (size_t)DM * DFF2), DM, DFF2, DFF2, WSP(bf16_t, WS_WUP) + (size_t)l * DFF2 * DM, INL(29, DM), scr, r, lane); continue; } r -= I_UP;
        transpose_item(INL(33, (size_t)DFF * DM), DFF, DM, DM, WSP(bf16_t, WS_WDN) + (size_t)l * DM * DFF, nullptr, scr, r, lane);
    }
    bf16_t* XB = WSP(bf16_t, WS_XB); float* RS = WSP(float, WS_CTL);
    for (int row = gw; row < TT; row += NGW) {
        const float* src = row < NPR ? A.in[0] + (size_t)row * DM : A.in[1] + (size_t)(row - NPR) * DM;
        float ss = 0.f;
#pragma unroll
        for (int j = 0; j < 8; ++j) { const f32x4 v = *(const f32x4*)(src + j * 256 + lane * 4);
            u32x2 w; w.x = pk2(v[0], v[1]); w.y = pk2(v[2], v[3]); *(u32x2*)(XB + (size_t)row * DM + j * 256 + lane * 4) = w;
            ss += (v[0] * v[0] + v[1] * v[1]) + (v[2] * v[2] + v[3] * v[3]); }
        ss = wave_sum(ss);
        if (lane == 0) RS[row] = ss;
    }
}

__device__ __forceinline__ f32x4 ld_prev4(const Args& A, int l, const float* P, int row, int col) {
    if (row < NPR) { if ((row & (SEQ - 1)) == 0) return (f32x4){0.f, 0.f, 0.f, 0.f}; return *(const f32x4*)(P + (size_t)(row - 1) * LDP + col); }
    const int s = row - NPR; if ((s & 3) == 0) return *(const f32x4*)(A.in[6] + ((size_t)l * 128 + (s >> 2)) * RWC + (col - RW0));
    return *(const f32x4*)(P + (size_t)(row - 1) * LDP + col);
}
__device__ __forceinline__ f32x2 ld_prev2(const Args& A, int l, const float* P, int row, int col) {
    if (row < NPR) { if ((row & (SEQ - 1)) == 0) return (f32x2){0.f, 0.f}; return *(const f32x2*)(P + (size_t)(row - 1) * LDP + col); }
    const int s = row - NPR; if ((s & 3) == 0) return *(const f32x2*)(A.in[6] + ((size_t)l * 128 + (s >> 2)) * RWC + (col - RW0));
    return *(const f32x2*)(P + (size_t)(row - 1) * LDP + col);
}
__device__ __forceinline__ float ld_prev1(const Args& A, int l, const float* P, int row, int col) {
    if (row < NPR) { if ((row & (SEQ - 1)) == 0) return 0.f; return P[(size_t)(row - 1) * LDP + col]; }
    const int s = row - NPR; if ((s & 3) == 0) return A.in[6][((size_t)l * 128 + (s >> 2)) * RWC + (col - RW0)];
    return P[(size_t)(row - 1) * LDP + col];
}

__device__ __forceinline__ void sgu_prompt(const Args& A, int l, LAS unsigned char* lds, int item);
constexpr int C1_ROWS = 34;
__device__ __forceinline__ void phase_c1(const Args& A, int l, LAS unsigned char* lds) {
    int tid = threadIdx.x; asm volatile("" : "+v"(tid)); const int lane = tid & 63, wave = tid >> 6, G = gridDim.x;
    const float* P = WSP(float, WS_P);
    const float* mu = INL(13, RWC);
    LAS float* in_s = (LAS float*)lds;
    float* DEC = WSP(float, WS_DEC); float* AAp = WSP(float, WS_AA); float* KKN = WSP(float, WS_KKN); bf16_t* GG = WSP(bf16_t, WS_GG);
    const float* w_up = INL(15, 64 * 1024); const float* a_up = INL(17, 64 * 1024); const float* g_up = INL(18, 128 * 1024);
    const int c0 = tid * 2;
    for (int tile = blockIdx.x; tile < TT / C1_ROWS; tile += G) {
        const int row0 = tile * C1_ROWS;
        __syncthreads();
        for (int idx = tid; idx < C1_ROWS * 64; idx += 512) {
            const int rr = idx >> 6, c4 = (idx & 63) * 4, row = row0 + rr;
            const f32x4 pf = *(const f32x4*)(P + (size_t)row * LDP + RW_LW + c4);
            const f32x4 pv = ld_prev4(A, l, P, row, RW_LW + c4);
            const f32x4 m4 = *(const f32x4*)(mu + (RW_LW - RW0) + c4);
            f32x4 px = pf + (pv - pf) * m4;
            if (c4 < 64) { for (int e = 0; e < 4; ++e) { const float ex = __expf(-2.0f * fabsf(px[e])); const float th = (1.0f - ex) / (1.0f + ex); px[e] = px[e] < 0.f ? -th : th; } }
            else if (c4 >= 128) { px[0] = sigmoidf_(px[0]); px[1] = sigmoidf_(px[1]); px[2] = sigmoidf_(px[2]); px[3] = sigmoidf_(px[3]); }
            *(LAS f32x4*)(in_s + rr * 256 + c4) = px;
        }
        __syncthreads();
#define C1_LORA(WPTR, NJ4, INOFF) { f32x2 wn[4]; \
            _Pragma("unroll") for (int i = 0; i < 4; ++i) wn[i] = *(const f32x2*)((WPTR) + (size_t)i * 1024 + c0); \
            for (int j4 = 0; j4 < (NJ4); ++j4) { f32x2 wv[4]; \
                _Pragma("unroll") for (int i = 0; i < 4; ++i) wv[i] = wn[i]; \
                const int jn = (j4 + 1 < (NJ4)) ? j4 + 1 : j4; \
                _Pragma("unroll") for (int i = 0; i < 4; ++i) wn[i] = *(const f32x2*)((WPTR) + (size_t)(jn * 4 + i) * 1024 + c0); \
                _Pragma("unroll") for (int t = 0; t < C1_ROWS; ++t) { const f32x4 x = *(const LAS f32x4*)(in_s + t * 256 + (INOFF) + j4 * 4); \
                    acc[t] += wv[0] * x[0]; acc[t] += wv[1] * x[1]; acc[t] += wv[2] * x[2]; acc[t] += wv[3] * x[3]; } } }
        {
            f32x2 acc[C1_ROWS];
            const f32x2 b0 = *(const f32x2*)(INL(14, 1024) + c0);
#pragma unroll
            for (int t = 0; t < C1_ROWS; ++t) acc[t] = b0;
            C1_LORA(w_up, 16, 0)
#pragma unroll
            for (int t = 0; t < C1_ROWS; ++t) { f32x2 o;
#pragma unroll
                for (int e = 0; e < 2; ++e) { const float wl = acc[t][e]; const float z = -wl; const float sp = fmaxf(z, 0.f) + log1pexp_negabs(z); const float wlog = -sp - 0.5f; o[e] = __expf(-__expf(wlog)); }
                *(f32x2*)(DEC + (size_t)(row0 + t) * 1024 + c0) = o; }
        }
        {
            f32x2 acc[C1_ROWS];
            const f32x2 b0 = *(const f32x2*)(INL(16, 1024) + c0);
#pragma unroll
            for (int t = 0; t < C1_ROWS; ++t) acc[t] = b0;
            C1_LORA(a_up, 16, 64)
#pragma unroll
            for (int t = 0; t < C1_ROWS; ++t) { f32x2 o; o[0] = sigmoidf_(acc[t][0]); o[1] = sigmoidf_(acc[t][1]); *(f32x2*)(AAp + (size_t)(row0 + t) * 1024 + c0) = o; }
        }
        {
            f32x2 acc[C1_ROWS];
#pragma unroll
            for (int t = 0; t < C1_ROWS; ++t) acc[t] = (f32x2){0.f, 0.f};
            C1_LORA(g_up, 32, 128)
#pragma unroll
            for (int t = 0; t < C1_ROWS; ++t) *(unsigned*)(GG + (size_t)(row0 + t) * 1024 + c0) = pk2(acc[t][0], acc[t][1]);
        }
#undef C1_LORA
        {
            const f32x2 kk2 = *(const f32x2*)(INL(19, 1024) + c0);
            const f32x2 mk = *(const f32x2*)(mu + (RW_K - RW0) + c0);
            for (int th = 0; th < 2; ++th) {
                f32x2 pf[17], pv[17];
#pragma unroll
                for (int t = 0; t < 17; ++t) { const int row = row0 + th * 17 + t; pf[t] = *(const f32x2*)(P + (size_t)row * LDP + RW_K + c0); pv[t] = ld_prev2(A, l, P, row, RW_K + c0); }
#pragma unroll
                for (int t = 0; t < 17; ++t) { const int row = row0 + th * 17 + t;
                    const f32x2 k = pf[t] + (pv[t] - pf[t]) * mk; f32x2 kk = k * kk2;
                    float ss = kk[0] * kk[0] + kk[1] * kk[1]; ss = row16_sum(ss); ss += __shfl_xor(ss, 16);
                    const float inv = rsqrtf(fmaxf(ss, 1e-24f));
                    *(f32x2*)(KKN + (size_t)row * 1024 + c0) = kk * inv; }
            }
        }
    }
    {
        f32x4* GATE = WSP(f32x4, WS_GATE);
        const float* b_i = INL(10, 4); const float* b_f = INL(11, 4);
        const int gw = blockIdx.x * 8 + wave, NGW = G * 8;
        for (int it = gw; it < (TT / 64) * 4; it += NGW) {
            const int h = it & 3, ch = it >> 2, row = ch * 64 + lane;
            const int segl = row < NPR ? 64 : 4;
            const float ig = P[(size_t)row * LDP + ML_IG + h] + b_i[h];
            const float fp = P[(size_t)row * LDP + ML_FG + h] + b_f[h];
            const float lf = fminf(fp, 0.f) - log1pexp_negabs(fp);
            float b = lf;
            for (int off = 1; off < segl; off <<= 1) { const float v = __shfl_up(b, off); if ((lane & (segl - 1)) >= off) b += v; }
            const float c = ig - b; float pm = c;
            for (int off = 1; off < segl; off <<= 1) { const float v = __shfl_up(pm, off); if ((lane & (segl - 1)) >= off) pm = fmaxf(pm, v); }
            GATE[(size_t)row * 4 + h] = (f32x4){c, pm, b, 0.f};
        }
    }
}

__device__ __forceinline__ float row8_sum(float x) { x += dpp_f<0xB1>(x); x += dpp_f<0x4E>(x); x += dpp_f<0x141>(x); return x; }
#define LO2(v) __builtin_shufflevector(v, v, 0, 1)
#define HI2(v) __builtin_shufflevector(v, v, 2, 3)
__device__ __forceinline__ void rwkv_prompt(const Args& A, int l, LAS unsigned char* lds, int item) {
    int tid = threadIdx.x; asm volatile("" : "+v"(tid)); const int lane = tid & 63, wave = tid >> 6;
    const int bh = item >> 1, b = bh >> 4, h = bh & 15, v0 = (item & 1) * 32, rowbase = b * SEQ;
    const int rr = lane >> 3, j = lane & 7, pi = (wave & 3) * 8 + rr, vrow = v0 + pi;
    const bool cwave = wave < 4;
    const float* P = WSP(float, WS_P);
    const float* DEC = WSP(float, WS_DEC); const float* AAp = WSP(float, WS_AA); const float* KKN = WSP(float, WS_KKN); float* Y = WSP(float, WS_Y);
    const float* mu = INL(13, RWC);
    LAS float* buf = (LAS float*)lds;
    LAS float* ybuf = buf + 2 * 6 * 32 * 64;
    constexpr int NB = SEQ / 32;
    f32x2 S0 = (f32x2){0.f, 0.f}, S1 = S0, S2 = S0, S3 = S0;
    const int pt = tid & 255, jj = pt & 15, tok0 = pt >> 4, ch = h * 64 + 4 * jj;
    const f32x4 mu_r = *(const f32x4*)(mu + (RW_R - RW0) + ch), mu_k = *(const f32x4*)(mu + (RW_K - RW0) + ch), mu_v = *(const f32x4*)(mu + (RW_V - RW0) + ch);
    const f32x4 ka = *(const f32x4*)(INL(20, 1024) + ch), rk4 = *(const f32x4*)(INL(21, 1024) + ch);
    float* BC = WSP(float, WS_BC);
    f32x4 pr[2], pk[2], pv[2], qr[2], qk[2], qv[2], dd[2], aa[2], kn[2];
#define RW_LOAD(bt) do { _Pragma("unroll") for (int u_ = 0; u_ < 2; ++u_) { const int row_ = rowbase + (bt) * 32 + tok0 + 16 * u_; \
        pr[u_] = *(const f32x4*)(P + (size_t)row_ * LDP + RW_R + ch); pk[u_] = *(const f32x4*)(P + (size_t)row_ * LDP + RW_K + ch); pv[u_] = *(const f32x4*)(P + (size_t)row_ * LDP + RW_V + ch); \
        qr[u_] = ld_prev4(A, l, P, row_, RW_R + ch); qk[u_] = ld_prev4(A, l, P, row_, RW_K + ch); qv[u_] = ld_prev4(A, l, P, row_, RW_V + ch); \
        dd[u_] = *(const f32x4*)(DEC + (size_t)row_ * 1024 + ch); aa[u_] = *(const f32x4*)(AAp + (size_t)row_ * 1024 + ch); kn[u_] = *(const f32x4*)(KKN + (size_t)row_ * 1024 + ch); } } while (0)
#define RW_STAGE(bt) do { LAS float* bw_ = buf + ((bt) & 1) * (6 * 32 * 64); _Pragma("unroll") for (int u_ = 0; u_ < 2; ++u_) { const int tok_ = tok0 + 16 * u_; \
        const f32x4 r_ = pr[u_] + (qr[u_] - pr[u_]) * mu_r, k_ = pk[u_] + (qk[u_] - pk[u_]) * mu_k, v_ = pv[u_] + (qv[u_] - pv[u_]) * mu_v; \
        const f32x4 k2_ = k_ * (1.0f + (aa[u_] - 1.0f) * ka); \
        { const f32x4 t3_ = r_ * k2_ * rk4; const float bc_ = row16_sum((t3_[0] + t3_[1]) + (t3_[2] + t3_[3])); if (jj == 0 && (item & 1) == 0) BC[(size_t)(rowbase + (bt) * 32 + tok_) * 16 + h] = bc_; } \
        *(LAS f32x4*)(bw_ + (0 * 32 + tok_) * 64 + 4 * jj) = dd[u_]; *(LAS f32x4*)(bw_ + (1 * 32 + tok_) * 64 + 4 * jj) = -kn[u_]; *(LAS f32x4*)(bw_ + (2 * 32 + tok_) * 64 + 4 * jj) = kn[u_] * aa[u_]; \
        *(LAS f32x4*)(bw_ + (3 * 32 + tok_) * 64 + 4 * jj) = k2_; *(LAS f32x4*)(bw_ + (4 * 32 + tok_) * 64 + 4 * jj) = r_; *(LAS f32x4*)(bw_ + (5 * 32 + tok_) * 64 + 4 * jj) = v_; } } while (0)
#define RW_FLUSH(btx) do { _Pragma("unroll") for (int u_ = 0; u_ < 2; ++u_) { const int i_ = pt + 256 * u_, s_ = i_ >> 4, c2_ = (i_ & 15) * 2; const f32x2 yv_ = *(const LAS f32x2*)(ybuf + ((btx) & 1) * 1024 + s_ * 32 + c2_); \
        *(f32x2*)(Y + (size_t)(rowbase + (btx) * 32 + s_) * 1024 + h * 64 + v0 + c2_) = yv_; } } while (0)
    __syncthreads();
    if (!cwave) { RW_LOAD(0); RW_STAGE(0); RW_LOAD(1); }
    __syncthreads();
    for (int bt = 0; bt < NB; ++bt) {
        if (cwave) {
            const LAS float* bb = buf + (bt & 1) * (6 * 32 * 64);
            LAS float* yb = ybuf + (bt & 1) * 1024;
            const LAS float* bj = bb + 8 * j;
            const LAS float* bv = bb + (5 * 32) * 64 + vrow;
#define RW_LD8(vec, st, lo, hi) const f32x4 lo = *(const LAS f32x4*)(bj + ((vec) * 32 + (st)) * 64), hi = *(const LAS f32x4*)(bj + ((vec) * 32 + (st)) * 64 + 4)
            f32x4 cw0, cw1, ca0, ca1, cb0, cb1, ck0, ck1, cr0, cr1; float cv;
            { RW_LD8(0, 0, a_, b_); cw0 = a_; cw1 = b_; } { RW_LD8(1, 0, a_, b_); ca0 = a_; ca1 = b_; } { RW_LD8(2, 0, a_, b_); cb0 = a_; cb1 = b_; }
            { RW_LD8(3, 0, a_, b_); ck0 = a_; ck1 = b_; } { RW_LD8(4, 0, a_, b_); cr0 = a_; cr1 = b_; } cv = bv[0];
#pragma unroll 8
            for (int s = 0; s < 32; ++s) {
                const int sn = (s + 1) & 31;
                RW_LD8(0, sn, nw0, nw1); RW_LD8(1, sn, na0, na1); RW_LD8(2, sn, nb0, nb1); RW_LD8(3, sn, nk0, nk1); RW_LD8(4, sn, nr0, nr1); const float nv = bv[sn * 64];
                f32x2 t2 = S0 * LO2(ca0); t2 += S1 * HI2(ca0); t2 += S2 * LO2(ca1); t2 += S3 * HI2(ca1);
                const float sa = row8_sum(t2[0] + t2[1]);
                S0 = S0 * LO2(cw0) + LO2(ck0) * cv; S1 = S1 * HI2(cw0) + HI2(ck0) * cv; S2 = S2 * LO2(cw1) + LO2(ck1) * cv; S3 = S3 * HI2(cw1) + HI2(ck1) * cv;
                S0 += LO2(cb0) * sa; S1 += HI2(cb0) * sa; S2 += LO2(cb1) * sa; S3 += HI2(cb1) * sa;
                f32x2 u2 = S0 * LO2(cr0); u2 += S1 * HI2(cr0); u2 += S2 * LO2(cr1); u2 += S3 * HI2(cr1);
                const float y = row8_sum(u2[0] + u2[1]);
                yb[s * 32 + pi] = y;
                cw0 = nw0; cw1 = nw1; ca0 = na0; ca1 = na1; cb0 = nb0; cb1 = nb1; ck0 = nk0; ck1 = nk1; cr0 = nr0; cr1 = nr1; cv = nv;
            }
#undef RW_LD8
        } else {
            if (bt + 1 < NB) RW_STAGE(bt + 1);
            if (bt + 2 < NB) RW_LOAD(bt + 2);
            if (bt > 0) RW_FLUSH(bt - 1);
        }
        __syncthreads();
    }
    if (!cwave) RW_FLUSH(NB - 1);
#undef RW_LOAD
#undef RW_STAGE
#undef RW_FLUSH
    if (cwave) {
        float* So = A.out + O_SP + (size_t)((l * 4 + b) * 16 + h) * 64 * 64 + (size_t)vrow * 64 + 8 * j;
        *(f32x4*)(So) = (f32x4){S0[0], S0[1], S1[0], S1[1]};
        *(f32x4*)(So + 4) = (f32x4){S2[0], S2[1], S3[0], S3[1]};
    }
    __syncthreads();
}
__device__ __forceinline__ void rwkv_sample2(const Args& A, int l, LAS unsigned char* lds, int item) {
    int tid = threadIdx.x; asm volatile("" : "+v"(tid)); const int lane = tid & 63, wave = tid >> 6;
    const int b = item >> 3, h0 = (item & 7) * 2, rowbase = NPR + b * 4;
    const int rr = lane >> 4, j = lane & 15;
    const float* P = WSP(float, WS_P);
    const float* DEC = WSP(float, WS_DEC); const float* AAp = WSP(float, WS_AA); const float* KKN = WSP(float, WS_KKN); float* Y = WSP(float, WS_Y);
    const float* mu = INL(13, RWC);
    LAS float* buf = (LAS float*)lds;
    const float* S0 = A.in[5] + (size_t)((l * 128 + b) * 16 + h0) * 64 * 64;
    float* So = A.out + O_SS + (size_t)((l * 128 + b) * 16 + h0) * 64 * 64;
    f32x4 S[4];
#pragma unroll
    for (int q = 0; q < 4; ++q) { const int vrow = (q & 1) * 32 + wave * 4 + rr; S[q] = *(const f32x4*)(S0 + (size_t)(q >> 1) * 4096 + (size_t)vrow * 64 + 4 * j); }
    if (tid < 128) {
        const int hd = tid >> 6, tok = (tid >> 4) & 3, jj = tid & 15, ch = (h0 + hd) * 64 + 4 * jj, row = rowbase + tok;
        const f32x4 mu_r = *(const f32x4*)(mu + (RW_R - RW0) + ch), mu_k = *(const f32x4*)(mu + (RW_K - RW0) + ch), mu_v = *(const f32x4*)(mu + (RW_V - RW0) + ch);
        const f32x4 ka = *(const f32x4*)(INL(20, 1024) + ch);
        const f32x4 pr = *(const f32x4*)(P + (size_t)row * LDP + RW_R + ch), pk = *(const f32x4*)(P + (size_t)row * LDP + RW_K + ch), pv = *(const f32x4*)(P + (size_t)row * LDP + RW_V + ch);
        const f32x4 qr = ld_prev4(A, l, P, row, RW_R + ch), qk = ld_prev4(A, l, P, row, RW_K + ch), qv = ld_prev4(A, l, P, row, RW_V + ch);
        const f32x4 dd = *(const f32x4*)(DEC + (size_t)row * 1024 + ch), aa = *(const f32x4*)(AAp + (size_t)row * 1024 + ch), kn = *(const f32x4*)(KKN + (size_t)row * 1024 + ch);
        const f32x4 r = pr + (qr - pr) * mu_r, k = pk + (qk - pk) * mu_k, v = pv + (qv - pv) * mu_v;
        const f32x4 k2 = k * (1.0f + (aa - 1.0f) * ka);
        { const f32x4 t3 = r * k2 * *(const f32x4*)(INL(21, 1024) + ch); const float bc = row16_sum((t3[0] + t3[1]) + (t3[2] + t3[3])); if (jj == 0) WSP(float, WS_BC)[(size_t)row * 16 + h0 + hd] = bc; }
        LAS float* bb = buf + hd * (6 * 4 * 64);
        *(LAS f32x4*)(bb + (0 * 4 + tok) * 64 + 4 * jj) = dd;
        *(LAS f32x4*)(bb + (1 * 4 + tok) * 64 + 4 * jj) = -kn;
        *(LAS f32x4*)(bb + (2 * 4 + tok) * 64 + 4 * jj) = kn * aa;
        *(LAS f32x4*)(bb + (3 * 4 + tok) * 64 + 4 * jj) = k2;
        *(LAS f32x4*)(bb + (4 * 4 + tok) * 64 + 4 * jj) = r;
        *(LAS f32x4*)(bb + (5 * 4 + tok) * 64 + 4 * jj) = v;
    }
    __syncthreads();
#pragma unroll
    for (int t = 0; t < 4; ++t) {
#pragma unroll
        for (int q = 0; q < 4; ++q) { const int hd = q >> 1, vrow = (q & 1) * 32 + wave * 4 + rr; const LAS float* bb = buf + hd * (6 * 4 * 64);
            const f32x4 w4 = *(const LAS f32x4*)(bb + (0 * 4 + t) * 64 + 4 * j), a4 = *(const LAS f32x4*)(bb + (1 * 4 + t) * 64 + 4 * j), b4 = *(const LAS f32x4*)(bb + (2 * 4 + t) * 64 + 4 * j),
                        k4 = *(const LAS f32x4*)(bb + (3 * 4 + t) * 64 + 4 * j), r4 = *(const LAS f32x4*)(bb + (4 * 4 + t) * 64 + 4 * j); const float vv = bb[(5 * 4 + t) * 64 + vrow];
            float sa = (S[q][0] * a4[0] + S[q][1] * a4[1]) + (S[q][2] * a4[2] + S[q][3] * a4[3]);
            sa = row16_sum(sa);
            S[q] = S[q] * w4 + k4 * vv;
            S[q] = S[q] + b4 * sa;
            float y = (S[q][0] * r4[0] + S[q][1] * r4[1]) + (S[q][2] * r4[2] + S[q][3] * r4[3]);
            y = row16_sum(y);
            if (j == 0) Y[(size_t)(rowbase + t) * 1024 + (h0 + hd) * 64 + vrow] = y; }
    }
#pragma unroll
    for (int q = 0; q < 4; ++q) { const int vrow = (q & 1) * 32 + wave * 4 + rr; *(f32x4*)(So + (size_t)(q >> 1) * 4096 + (size_t)vrow * 64 + 4 * j) = S[q]; }
    __syncthreads();
}

__device__ __forceinline__ void mlstm_prompt(const Args& A, int l, LAS unsigned char* lds, int bh, int half) {
    int tid = threadIdx.x; asm volatile("" : "+v"(tid)); const int lane = tid & 63, wave = __builtin_amdgcn_readfirstlane(tid >> 6), fr = lane & 15, fq = lane >> 4;
    const int b = bh >> 2, h = bh & 3, eo = half * 4;
    const float* P = WSP(float, WS_P); const f32x4* GATE = WSP(f32x4, WS_GATE); float* HM = WSP(float, WS_HM);
    LAS bf16_t* Qs = (LAS bf16_t*)(lds);
    LAS bf16_t* Ks = (LAS bf16_t*)(lds + 17408);
    LAS bf16_t* Vt = (LAS bf16_t*)(lds + 34816);
    LAS bf16_t* Kwt = (LAS bf16_t*)(lds + 55552);
    LAS bf16_t* Ct = (LAS bf16_t*)(lds + 73984);
    LAS bf16_t* Att = (LAS bf16_t*)(lds + 113152);
    LAS float* gf = (LAS float*)(lds + 122368);
    LAS float *cs = gf, *Mt = gf + 64, *si = gf + 128, *fl = gf + 192, *den = gf + 256, *wk = gf + 320, *misc = gf + 384;
    __syncthreads();
    for (int i = tid; i < 144 * 136 / 2; i += 512) ((LAS unsigned*)Ct)[i] = 0u;
    for (int i = tid; i < 64 * 72 / 2; i += 512) ((LAS unsigned*)Att)[i] = 0u;
    for (int i = tid; i < 16 * 72; i += 512) Vt[64 * 72 + i] = (i < 64) ? (bf16_t)0x3F80 : (bf16_t)0;
    f32x4 cacc[5];
#pragma unroll
    for (int e = 0; e < 5; ++e) cacc[e] = (f32x4){0.f, 0.f, 0.f, 0.f};
    float m = 0.f;
    const float kscale = 0.08838834764831845f;
    f32x4 nq[4], nk[4], nv[4]; f32x4 gnx = (f32x4){0.f, 0.f, 0.f, 0.f};
#define ML_SWZ(r, cchunk) ((((cchunk) ^ (((r) >> 2) & 7))) << 3)
#define ML_LOAD(c) do { if (tid < 64) gnx = GATE[(size_t)(b * SEQ + (c) * 64 + tid) * 4 + h];  const int row0_ = b * SEQ + (c) * 64; _Pragma("unroll") for (int i = 0; i < 4; ++i) { const int idx = tid + i * 512, t = idx >> 5, d4 = (idx & 31) * 4; const float* pp = P + (size_t)(row0_ + t) * LDP + h * 128 + d4; \
        nq[i] = *(const f32x4*)(pp + ML_Q); nk[i] = *(const f32x4*)(pp + ML_K); nv[i] = *(const f32x4*)(pp + ML_V); } } while (0)
    ML_LOAD(0);
    __syncthreads();
    for (int c = 0; c < 32; ++c) {
        const int row0 = b * SEQ + c * 64;
        if (tid < 64) {
            const f32x4 g = gnx;
            const float M = fmaxf(m, g[1]);
            cs[tid] = g[0]; Mt[tid] = M; si[tid] = __expf(m - M); fl[tid] = __expf(-(g[2] + M));
            const float M63 = rlane(M, 63), b63 = rlane(g[2], 63);
            wk[tid] = __expf(g[0] - M63);
            if (tid == 0) misc[0] = b63 + M63;
        }
        __syncthreads();
        m = misc[0];
#pragma unroll
        for (int i = 0; i < 4; ++i) { const int idx = tid + i * 512, t = idx >> 5, d4 = (idx & 31) * 4; const float w = wk[t];
            u32x2 q2; q2.x = pk2(nq[i][0], nq[i][1]); q2.y = pk2(nq[i][2], nq[i][3]); *(LAS u32x2*)(Qs + t * 136 + d4) = q2;
            const f32x4 ks = nk[i] * kscale;
            u32x2 k2; k2.x = pk2(ks[0], ks[1]); k2.y = pk2(ks[2], ks[3]); *(LAS u32x2*)(Ks + t * 136 + d4) = k2;
#pragma unroll
            for (int e = 0; e < 4; ++e) { const int sw = (d4 + e) * 72 + ML_SWZ(d4 + e, t >> 3) + (t & 7); Kwt[sw] = (bf16_t)f2bf(ks[e] * w);
                if ((d4 >> 6) == half) { const int rl_ = (d4 & 63) + e; Vt[rl_ * 72 + ML_SWZ(rl_, t >> 3) + (t & 7)] = (bf16_t)f2bf(nv[i][e]); } } }
        __syncthreads();
        if (c + 1 < 32) ML_LOAD(c + 1);
        for (int tl = wave; tl < 10; tl += 8) {
            int ti, sj; if (tl < 1) { ti = 0; sj = 0; } else if (tl < 3) { ti = 1; sj = tl - 1; } else if (tl < 6) { ti = 2; sj = tl - 3; } else { ti = 3; sj = tl - 6; }
            f32x4 acc = (f32x4){0.f, 0.f, 0.f, 0.f};
#pragma unroll
            for (int ks = 0; ks < 4; ++ks) { const bf16x8 a = *(const LAS bf16x8*)(Qs + (ti * 16 + fr) * 136 + ks * 32 + fq * 8); const bf16x8 bb = *(const LAS bf16x8*)(Ks + (sj * 16 + fr) * 136 + ks * 32 + fq * 8);
                acc = __builtin_amdgcn_mfma_f32_16x16x32_bf16(a, bb, acc, 0, 0, 0); }
            const int s = sj * 16 + fr; const float csv = cs[s];
#pragma unroll
            for (int jx = 0; jx < 4; ++jx) { const int t = ti * 16 + fq * 4 + jx; const float v = (s <= t) ? acc[jx] * __expf(csv - Mt[t]) : 0.f; Att[t * 72 + s] = (bf16_t)f2bf(v); }
        }
        __syncthreads();
        const int ti = wave & 3, e0 = (wave >> 2) ? 3 : 0, e1 = (wave >> 2) ? 5 : 3;
        f32x4 o[3];
        {
            bf16x8 qa[4], aa2[2];
#pragma unroll
            for (int ks = 0; ks < 4; ++ks) qa[ks] = *(const LAS bf16x8*)(Qs + (ti * 16 + fr) * 136 + ks * 32 + fq * 8);
#pragma unroll
            for (int ks = 0; ks < 2; ++ks) aa2[ks] = *(const LAS bf16x8*)(Att + (ti * 16 + fr) * 72 + ks * 32 + fq * 8);
            float sv[4];
#pragma unroll
            for (int jx = 0; jx < 4; ++jx) sv[jx] = si[ti * 16 + fq * 4 + jx];
#pragma unroll
            for (int ei = 0; ei < 3; ++ei) { const int et = e0 + ei; if (et < e1) {
                f32x4 acc = (f32x4){0.f, 0.f, 0.f, 0.f};
#pragma unroll
                for (int ks = 0; ks < 4; ++ks) { const bf16x8 bb = *(const LAS bf16x8*)(Ct + (et * 16 + fr) * 136 + ks * 32 + fq * 8); acc = __builtin_amdgcn_mfma_f32_16x16x32_bf16(qa[ks], bb, acc, 0, 0, 0); }
#pragma unroll
                for (int jx = 0; jx < 4; ++jx) acc[jx] *= sv[jx];
#pragma unroll
                for (int ks = 0; ks < 2; ++ks) { const bf16x8 bb = *(const LAS bf16x8*)(Vt + (et * 16 + fr) * 72 + ML_SWZ(et * 16 + fr, ks * 4 + fq)); acc = __builtin_amdgcn_mfma_f32_16x16x32_bf16(aa2[ks], bb, acc, 0, 0, 0); }
                o[ei] = acc;
                if (et == 4 && fr == 0) {
#pragma unroll
                    for (int jx = 0; jx < 4; ++jx) den[ti * 16 + fq * 4 + jx] = acc[jx]; }
            } }
        }
        __syncthreads();
        {
            float dn[4];
#pragma unroll
            for (int jx = 0; jx < 4; ++jx) { const int t = ti * 16 + fq * 4 + jx; dn[jx] = 1.0f / fmaxf(fabsf(den[t]), fl[t]); }
#pragma unroll
            for (int ei = 0; ei < 3; ++ei) { const int et = e0 + ei; if (et < e1 && et < 4) {
#pragma unroll
                for (int jx = 0; jx < 4; ++jx) { const int t = ti * 16 + fq * 4 + jx; HM[(size_t)(row0 + t) * 512 + h * 128 + (eo + et) * 16 + fr] = o[ei][jx] * dn[jx]; } } }
        }
        {
            const float dec = si[63];
            bf16x8 kb[2];
#pragma unroll
            for (int ks = 0; ks < 2; ++ks) kb[ks] = *(const LAS bf16x8*)(Kwt + (wave * 16 + fr) * 72 + ML_SWZ(wave * 16 + fr, ks * 4 + fq));
#pragma unroll
            for (int et = 0; et < 5; ++et) { f32x4 acc = cacc[et] * dec;
#pragma unroll
                for (int ks = 0; ks < 2; ++ks) { const bf16x8 va = *(const LAS bf16x8*)(Vt + (et * 16 + fr) * 72 + ML_SWZ(et * 16 + fr, ks * 4 + fq)); acc = __builtin_amdgcn_mfma_f32_16x16x32_bf16(va, kb[ks], acc, 0, 0, 0); }
                cacc[et] = acc;
#pragma unroll
                for (int jx = 0; jx < 4; ++jx) Ct[(et * 16 + fq * 4 + jx) * 136 + wave * 16 + fr] = (bf16_t)f2bf(acc[jx]); }
        }
        __syncthreads();
    }
#undef ML_LOAD
#undef ML_SWZ
    {
        float* Co = A.out + O_CP + (size_t)((l * 4 + b) * 4 + h) * 128 * 128;
        const int d = wave * 16 + fr;
#pragma unroll
        for (int et = 0; et < 4; ++et) *(f32x4*)(Co + (size_t)d * 128 + (eo + et) * 16 + fq * 4) = cacc[et];
        if (fq == 0 && half == 0) A.out[O_NP + (size_t)((l * 4 + b) * 4 + h) * 128 + d] = cacc[4][0];
        if (tid == 0 && half == 0) A.out[O_MP + (l * 4 + b) * 4 + h] = m;
    }
    __syncthreads();
}

__device__ __forceinline__ void mlstm_sample(const Args& A, int l, LAS unsigned char* lds, int item) {
    int tid = threadIdx.x; asm volatile("" : "+v"(tid)); const int lane = tid & 63, wave = tid >> 6;
    const int b = item >> 2, h = item & 3, row0 = NPR + b * 4;
    const float* P = WSP(float, WS_P); const f32x4* GATE = WSP(f32x4, WS_GATE); float* HM = WSP(float, WS_HM);
    LAS float* q = (LAS float*)lds;
    LAS float* k = q + 512;
    LAS float* v = k + 512;
    LAS float* att = v + 512;
    LAS float* gv = att + 16;
    LAS float* qn = gv + 32;
    LAS float* qc = qn + 32;
    const float* C0 = A.in[2] + (size_t)((l * 128 + b) * 4 + h) * 128 * 128;
    const float* n0 = A.in[3] + (size_t)((l * 128 + b) * 4 + h) * 128;
    const float m0 = A.in[4][(l * 128 + b) * 4 + h];
    const int rg = tid >> 5, e4 = (tid & 31) * 4;
    f32x4 cv[8];
#pragma unroll
    for (int p = 0; p < 8; ++p) cv[p] = *(const f32x4*)(C0 + (size_t)(p * 16 + rg) * 128 + e4);
    __syncthreads();
    { const int t = tid >> 7, d = tid & 127; const float* pp = P + (size_t)(row0 + t) * LDP + h * 128 + d;
      q[tid] = pp[ML_Q]; k[tid] = pp[ML_K] * 0.08838834764831845f; v[tid] = pp[ML_V]; }
    if (tid < 4) {
        const f32x4 g = GATE[(size_t)(row0 + tid) * 4 + h]; const float M = fmaxf(m0, g[1]);
        gv[tid] = __expf(m0 - M); gv[4 + tid] = __expf(-(g[2] + M)); gv[12 + tid] = g[0]; gv[16 + tid] = M;
        const float M3 = rlane(M, 3), b3 = rlane(g[2], 3);
        gv[8 + tid] = __expf(g[0] - M3);
        if (tid == 0) { gv[20] = __expf(m0 - M3); gv[21] = b3 + M3; }
    }
    __syncthreads();
    for (int pr = wave; pr < 16; pr += 8) { const int t = pr >> 2, s2 = pr & 3;
        float d = q[t * 128 + lane] * k[s2 * 128 + lane] + q[t * 128 + 64 + lane] * k[s2 * 128 + 64 + lane]; d = wave_sum(d);
        if (lane == 0) att[pr] = (s2 <= t) ? d * __expf(gv[12 + s2] - gv[16 + t]) : 0.f; }
    const float dec = gv[20];
    f32x4 v4[4]; float wkv[4];
#pragma unroll
    for (int s2 = 0; s2 < 4; ++s2) { wkv[s2] = gv[8 + s2]; v4[s2] = *(const LAS f32x4*)(v + s2 * 128 + e4); }
    f32x4 acc[4];
#pragma unroll
    for (int t = 0; t < 4; ++t) acc[t] = (f32x4){0.f, 0.f, 0.f, 0.f};
    float* Co = A.out + O_CS + (size_t)((l * 128 + b) * 4 + h) * 128 * 128;
#pragma unroll
    for (int p = 0; p < 8; ++p) { const int d = p * 16 + rg; f32x4 cn = cv[p] * dec;
#pragma unroll
        for (int s2 = 0; s2 < 4; ++s2) { acc[s2] += cv[p] * q[s2 * 128 + d]; cn += v4[s2] * (wkv[s2] * k[s2 * 128 + d]); }
        *(f32x4*)(Co + (size_t)d * 128 + e4) = cn; }
#pragma unroll
    for (int t = 0; t < 4; ++t) *(LAS f32x4*)(qc + (rg * 4 + t) * 128 + e4) = acc[t];
    if (tid < 128) { const float nv0 = n0[tid]; float nn = dec * nv0;
#pragma unroll
        for (int s2 = 0; s2 < 4; ++s2) nn += wkv[s2] * k[s2 * 128 + tid];
        A.out[O_NS + (size_t)((l * 128 + b) * 4 + h) * 128 + tid] = nn;
#pragma unroll
        for (int t = 0; t < 4; ++t) { float pq = q[t * 128 + tid] * nv0; pq = wave_sum(pq); if (lane == 0) qn[wave * 4 + t] = pq; } }
    if (tid == 0) A.out[O_MS + (l * 128 + b) * 4 + h] = gv[21];
    __syncthreads();
    { const int t = tid >> 7, e = tid & 127; const float sit = gv[t];
      float qs = 0.f;
#pragma unroll
      for (int r2 = 0; r2 < 16; ++r2) qs += qc[(r2 * 4 + t) * 128 + e];
      float num = sit * qs;
      float dn = sit * (qn[t] + qn[4 + t]);
#pragma unroll
      for (int s2 = 0; s2 < 4; ++s2) { const float a = att[t * 4 + s2]; num += a * v[s2 * 128 + e]; dn += a; }
      HM[(size_t)(row0 + t) * 512 + h * 128 + e] = num / fmaxf(fabsf(dn), gv[4 + t]); }
    __syncthreads();
}

__device__ __forceinline__ void sgu_prompt(const Args& A, int l, LAS unsigned char* lds, int item) {
    int tid = threadIdx.x; asm volatile("" : "+v"(tid));
    const int g = item & 3, chn = item >> 2, r0 = chn * 128;
    const float* P = WSP(float, WS_P); bf16_t* MIX = WSP(bf16_t, WS_MIX);
    LAS float* vn = (LAS float*)lds;
    LAS float* Wt = vn + 128 * 128;
    const float* Wg = INL(26, 4 * 128 * 128) + (size_t)g * 128 * 128;
    __syncthreads();
    { const int s = tid >> 2, qd = tid & 3; const float* pp = P + (size_t)(r0 + s) * LDP + SG_V + g * 128 + qd * 32;
      f32x4 z[8]; float sm = 0.f;
#pragma unroll
      for (int i = 0; i < 8; ++i) { z[i] = *(const f32x4*)(pp + 4 * i);
#pragma unroll
          for (int e = 0; e < 4; ++e) { z[i][e] = gelu_erf(z[i][e]); sm += z[i][e]; } }
      sm += __shfl_xor(sm, 1); sm += __shfl_xor(sm, 2); const float mean = sm * (1.0f / 128.0f); float sq = 0.f;
#pragma unroll
      for (int i = 0; i < 8; ++i)
#pragma unroll
          for (int e = 0; e < 4; ++e) { z[i][e] -= mean; sq += z[i][e] * z[i][e]; }
      sq += __shfl_xor(sq, 1); sq += __shfl_xor(sq, 2); const float rstd = rsqrtf(sq * (1.0f / 128.0f) + EPS);
      const float* lg = INL(24, 512) + g * 128 + qd * 32; const float* lb = INL(25, 512) + g * 128 + qd * 32;
#pragma unroll
      for (int i = 0; i < 8; ++i) { const f32x4 gg = *(const f32x4*)(lg + 4 * i), bb = *(const f32x4*)(lb + 4 * i); *(LAS f32x4*)(vn + s * 128 + qd * 32 + 4 * i) = z[i] * rstd * gg + bb; } }
    for (int idx = tid; idx < 128 * 32; idx += 512) { const int t = idx & 127, s4 = (idx >> 7) * 4; const f32x4 w = *(const f32x4*)(Wg + (size_t)t * 128 + s4);
#pragma unroll
        for (int e = 0; e < 4; ++e) Wt[(s4 + e) * 128 + t] = (s4 + e <= t) ? w[e] : 0.f; }
    __syncthreads();
    const int d = tid & 127, tq = tid >> 7, t0 = tq * 32;
    float acc[32];
#pragma unroll
    for (int i = 0; i < 32; ++i) acc[i] = 0.f;
    for (int s = 0; s < t0 + 32; ++s) { const float x = vn[s * 128 + d];
#pragma unroll
        for (int i4 = 0; i4 < 8; ++i4) { const f32x4 w = *(const LAS f32x4*)(Wt + s * 128 + t0 + 4 * i4);
#pragma unroll
            for (int e = 0; e < 4; ++e) acc[i4 * 4 + e] += w[e] * x; } }
    const float* bs = INL(27, 512) + g * 128;
#pragma unroll 4
    for (int i = 0; i < 32; ++i) { const int t = t0 + i; const float u = gelu_erf(P[(size_t)(r0 + t) * LDP + SG_U + g * 128 + d]);
        MIX[(size_t)(r0 + t) * DM + 1536 + g * 128 + d] = (bf16_t)f2bf(u * (acc[i] + bs[t])); }
    __syncthreads();
}
__device__ __forceinline__ void sgu_sample(const Args& A, int l, LAS unsigned char* lds, int b) {
    int tid = threadIdx.x; asm volatile("" : "+v"(tid)); const int lane = tid & 63, wave = tid >> 6, g = tid >> 7, r0 = NPR + b * 4;
    const float* P = WSP(float, WS_P); bf16_t* MIX = WSP(bf16_t, WS_MIX);
    LAS float* ex = (LAS float*)lds;
    float z[4];
    __syncthreads();
#pragma unroll
    for (int t = 0; t < 4; ++t) { z[t] = gelu_erf(P[(size_t)(r0 + t) * LDP + SG_V + tid]); const float s = wave_sum(z[t]); if (lane == 0) ex[wave * 4 + t] = s; }
    __syncthreads();
    float mean[4];
#pragma unroll
    for (int t = 0; t < 4; ++t) mean[t] = (ex[(2 * g) * 4 + t] + ex[(2 * g + 1) * 4 + t]) * (1.0f / 128.0f);
    __syncthreads();
#pragma unroll
    for (int t = 0; t < 4; ++t) { z[t] -= mean[t]; const float s = wave_sum(z[t] * z[t]); if (lane == 0) ex[wave * 4 + t] = s; }
    __syncthreads();
    const float lg = INL(24, 512)[tid], lb = INL(25, 512)[tid];
    float vnr[4];
#pragma unroll
    for (int t = 0; t < 4; ++t) { const float var = (ex[(2 * g) * 4 + t] + ex[(2 * g + 1) * 4 + t]) * (1.0f / 128.0f); vnr[t] = z[t] * rsqrtf(var + EPS) * lg + lb;
        A.out[O_VS + ((size_t)(l * 128 + b) * 4 + t) * 512 + tid] = vnr[t]; }
    const float* Wg = INL(26, 4 * 128 * 128) + (size_t)g * 128 * 128; const float* bs = INL(27, 512) + g * 128;
#pragma unroll
    for (int t = 0; t < 4; ++t) { float mx = bs[t];
#pragma unroll
        for (int s = 0; s < 4; ++s) if (s <= t) mx += Wg[t * 128 + s] * vnr[s];
        const float u = gelu_erf(P[(size_t)(r0 + t) * LDP + SG_U + tid]);
        MIX[(size_t)(r0 + t) * DM + 1536 + tid] = (bf16_t)f2bf(u * mx); }
    __syncthreads();
}

__device__ __forceinline__ void phase_c2(const Args& A, int l, LAS unsigned char* lds) {
    const int G = gridDim.x, blk = blockIdx.x;
    constexpr int N_RP = 128, N_MP = 32, N_LONG = N_RP + N_MP;
    constexpr int N_SGP = 256, N_SGS = 128, N_MS = 512, N_RS = 1024, N_OTHER = N_SGP + N_SGS + N_MS + N_RS;
    { int it = blk;
      for (; it < N_RP; it += G) rwkv_prompt(A, l, lds, it);
      for (; it < N_LONG; it += G) mlstm_prompt(A, l, lds, (it - N_RP) >> 1, (it - N_RP) & 1); }
    unsigned* qctr = (unsigned*)(A.ws + WS_CTL + 768 * 1024) + l * 64;
    volatile LAS unsigned* tick = (volatile LAS unsigned*)(lds + 131072 + 64 + 32);
    for (;;) {
        __syncthreads();
        if (threadIdx.x == 0) tick[0] = __hip_atomic_fetch_add(qctr, 1u, __ATOMIC_RELAXED, __HIP_MEMORY_SCOPE_AGENT);
        __syncthreads();
        const int it = (int)tick[0];
        if (it >= N_OTHER) break;
        if (it < N_SGP) sgu_prompt(A, l, lds, it);
        else if (it < N_SGP + N_MS) mlstm_sample(A, l, lds, it - N_SGP);
        else if (it < N_SGP + N_MS + N_RS) rwkv_sample2(A, l, lds, it - N_SGP - N_MS);
        else sgu_sample(A, l, lds, it - N_SGP - N_MS - N_RS);
    }
}

__device__ __forceinline__ void phase_c3(const Args& A, int l) {
    int tid = threadIdx.x; asm volatile("" : "+v"(tid)); const int lane = tid & 63, wave = tid >> 6, G = gridDim.x;
    const float* P = WSP(float, WS_P); const float* HM = WSP(float, WS_HM); const float* Y = WSP(float, WS_Y); const float* AAp = WSP(float, WS_AA); const bf16_t* GG = WSP(bf16_t, WS_GG);
    bf16_t* MIX = WSP(bf16_t, WS_MIX);
    const float* mu = INL(13, RWC);
    for (int it = blockIdx.x * 8 + wave; it < TT * 5; it += G * 8) {
        const int row = it / 5, part = it - row * 5;
        const float* prow = P + (size_t)row * LDP;
        if (part == 4) {
            const int c = lane * 8;
            const f32x4 x0 = *(const f32x4*)(HM + (size_t)row * 512 + c), x1 = *(const f32x4*)(HM + (size_t)row * 512 + c + 4);
            const f32x4 o0 = *(const f32x4*)(prow + ML_O + c), o1 = *(const f32x4*)(prow + ML_O + c + 4);
            const f32x4 g0 = *(const f32x4*)(INL(12, 512) + c), g1 = *(const f32x4*)(INL(12, 512) + c + 4);
            float ss = (x0[0] * x0[0] + x0[1] * x0[1]) + (x0[2] * x0[2] + x0[3] * x0[3]) + (x1[0] * x1[0] + x1[1] * x1[1]) + (x1[2] * x1[2] + x1[3] * x1[3]);
            ss = row16_sum(ss); const float r = rsqrtf(ss * (1.0f / 128.0f) + EPS);
            u32x4 w;
            w.x = pk2(x0[0] * r * g0[0] * sigmoidf_(o0[0]), x0[1] * r * g0[1] * sigmoidf_(o0[1])); w.y = pk2(x0[2] * r * g0[2] * sigmoidf_(o0[2]), x0[3] * r * g0[3] * sigmoidf_(o0[3]));
            w.z = pk2(x1[0] * r * g1[0] * sigmoidf_(o1[0]), x1[1] * r * g1[1] * sigmoidf_(o1[1])); w.w = pk2(x1[2] * r * g1[2] * sigmoidf_(o1[2]), x1[3] * r * g1[3] * sigmoidf_(o1[3]));
            *(u32x4*)(MIX + (size_t)row * DM + c) = w;
            int shb = -1; float* dst = nullptr;
            if (row < NPR) { if ((row & (SEQ - 1)) == SEQ - 1) { shb = row >> 11; dst = A.out + O_SHP + (size_t)(l * 4 + shb) * RWC; } }
            else { const int s2 = row - NPR; if ((s2 & 3) == 3) { shb = s2 >> 2; dst = A.out + O_SHS + (size_t)(l * 128 + shb) * RWC; } }
            if (shb >= 0) for (int cc = lane * 4; cc < RWC; cc += 256) *(f32x4*)(dst + cc) = *(const f32x4*)(prow + RW0 + cc);
        } else {
            const int c = part * 256 + lane * 4;
            const f32x4 y = *(const f32x4*)(Y + (size_t)row * 1024 + c);
            const f32x4 pv = *(const f32x4*)(prow + RW_V + c);
            const f32x4 qv = ld_prev4(A, l, P, row, RW_V + c);
            const u32x2 ggb = *(const u32x2*)(GG + (size_t)row * 1024 + c);
            const float bc = WSP(float, WS_BC)[(size_t)row * 16 + (c >> 6)];
            const f32x4 m_v = *(const f32x4*)(mu + (RW_V - RW0) + c);
            const f32x4 lg = *(const f32x4*)(INL(22, 1024) + c), lb = *(const f32x4*)(INL(23, 1024) + c);
            const float mean = row16_sum((y[0] + y[1]) + (y[2] + y[3])) * (1.0f / 64.0f);
            const f32x4 d = y - mean;
            const float var = row16_sum((d[0] * d[0] + d[1] * d[1]) + (d[2] * d[2] + d[3] * d[3])) * (1.0f / 64.0f);
            const f32x4 yn = d * rsqrtf(var + 64.0f * 1e-5f) * lg + lb;
            const f32x4 v = pv + (qv - pv) * m_v;
            f32x4 gg; gg[0] = __builtin_bit_cast(float, ggb.x << 16); gg[1] = __builtin_bit_cast(float, ggb.x & 0xffff0000u); gg[2] = __builtin_bit_cast(float, ggb.y << 16); gg[3] = __builtin_bit_cast(float, ggb.y & 0xffff0000u);
            const f32x4 o = (yn + v * bc) * gg;
            u32x2 w; w.x = pk2(o[0], o[1]); w.y = pk2(o[2], o[3]);
            *(u32x2*)(MIX + (size_t)row * DM + 512 + c) = w;
        }
    }
}

__device__ __forceinline__ void ld8(const bf16_t* p, float (&o)[8]) { const u32x4 w = *(const u32x4*)p; o[0] = __builtin_bit_cast(float, w.x << 16); o[1] = __builtin_bit_cast(float, w.x & 0xffff0000u); o[2] = __builtin_bit_cast(float, w.y << 16); o[3] = __builtin_bit_cast(float, w.y & 0xffff0000u);
    o[4] = __builtin_bit_cast(float, w.z << 16); o[5] = __builtin_bit_cast(float, w.z & 0xffff0000u); o[6] = __builtin_bit_cast(float, w.w << 16); o[7] = __builtin_bit_cast(float, w.w & 0xffff0000u); }
__device__ __forceinline__ void ld8f(const float* p, float (&o)[8]) { const f32x4 a = *(const f32x4*)p, b = *(const f32x4*)(p + 4); o[0] = a[0]; o[1] = a[1]; o[2] = a[2]; o[3] = a[3]; o[4] = b[0]; o[5] = b[1]; o[6] = b[2]; o[7] = b[3]; }
__device__ __forceinline__ void st8f(float* p, const float (&o)[8]) { *(f32x4*)p = (f32x4){o[0], o[1], o[2], o[3]}; *(f32x4*)(p + 4) = (f32x4){o[4], o[5], o[6], o[7]}; }
__device__ __forceinline__ void phase_f(const Args& A, int l) {
    const int G = gridDim.x; int tid = threadIdx.x; asm volatile("" : "+v"(tid));
    const bf16_t* HUP = WSP(bf16_t, WS_HUP); bf16_t* ACT = WSP(bf16_t, WS_ACT);
    const float* cw = INL(31, 3 * DFF2); const float* cb = INL(32, DFF2);
    constexpr int NFC = DFF / 8, RSTR = 8, NSTR = TT / RSTR;
    for (int it = blockIdx.x * 512 + tid; it < NFC * NSTR; it += G * 512) {
        const int fc = it % NFC, strip = it / NFC, f = fc * 8;
        float wg[3][8], wv[3][8], bg[8], bv[8];
#pragma unroll
        for (int j = 0; j < 3; ++j) { ld8f(cw + (size_t)j * DFF2 + f, wg[j]); ld8f(cw + (size_t)j * DFF2 + DFF + f, wv[j]); }
        ld8f(cb + f, bg); ld8f(cb + DFF + f, bv);
        const int rowb = strip * RSTR;
        u32x4 cg_[RSTR], cv_[RSTR];
#pragma unroll
        for (int rr = 0; rr < RSTR; ++rr) { cg_[rr] = *(const u32x4*)(HUP + (size_t)(rowb + rr) * DFF2 + f); cv_[rr] = *(const u32x4*)(HUP + (size_t)(rowb + rr) * DFF2 + DFF + f); }
        float g0[8], g1[8], v0[8], v1[8];
        if (rowb < NPR) {
            if ((rowb & (SEQ - 1)) == 0) {
#pragma unroll
                for (int e = 0; e < 8; ++e) { g0[e] = 0.f; g1[e] = 0.f; v0[e] = 0.f; v1[e] = 0.f; } }
            else { ld8(HUP + (size_t)(rowb - 2) * DFF2 + f, g0); ld8(HUP + (size_t)(rowb - 2) * DFF2 + DFF + f, v0); ld8(HUP + (size_t)(rowb - 1) * DFF2 + f, g1); ld8(HUP + (size_t)(rowb - 1) * DFF2 + DFF + f, v1); }
        }
#pragma unroll
        for (int rr = 0; rr < RSTR; ++rr) {
            const int row = rowb + rr;
            int t, Tn, bidx; if (row < NPR) { t = row & (SEQ - 1); Tn = SEQ; bidx = row >> 11; } else { t = (row - NPR) & 3; Tn = 4; bidx = (row - NPR) >> 2; }
            if (row >= NPR && t == 0) { const float* bp = A.in[7] + ((size_t)(l * 128 + bidx) * 2) * DFF2; ld8f(bp + f, g0); ld8f(bp + DFF + f, v0); ld8f(bp + DFF2 + f, g1); ld8f(bp + DFF2 + DFF + f, v1); }
            float hg[8], hv[8];
            { const u32x4 w = cg_[rr]; hg[0] = __builtin_bit_cast(float, w.x << 16); hg[1] = __builtin_bit_cast(float, w.x & 0xffff0000u); hg[2] = __builtin_bit_cast(float, w.y << 16); hg[3] = __builtin_bit_cast(float, w.y & 0xffff0000u);
              hg[4] = __builtin_bit_cast(float, w.z << 16); hg[5] = __builtin_bit_cast(float, w.z & 0xffff0000u); hg[6] = __builtin_bit_cast(float, w.w << 16); hg[7] = __builtin_bit_cast(float, w.w & 0xffff0000u); }
            { const u32x4 w = cv_[rr]; hv[0] = __builtin_bit_cast(float, w.x << 16); hv[1] = __builtin_bit_cast(float, w.x & 0xffff0000u); hv[2] = __builtin_bit_cast(float, w.y << 16); hv[3] = __builtin_bit_cast(float, w.y & 0xffff0000u);
              hv[4] = __builtin_bit_cast(float, w.z << 16); hv[5] = __builtin_bit_cast(float, w.z & 0xffff0000u); hv[6] = __builtin_bit_cast(float, w.w << 16); hv[7] = __builtin_bit_cast(float, w.w & 0xffff0000u); }
            float o[8];
#pragma unroll
            for (int e = 0; e < 8; ++e) { const float gt = bg[e] + wg[0][e] * g0[e] + wg[1][e] * g1[e] + wg[2][e] * hg[e]; const float vl = bv[e] + wv[0][e] * v0[e] + wv[1][e] * v1[e] + wv[2][e] * hv[e];
                o[e] = gt * sigmoidf_(gt) * vl; }
            u32x4 w; w.x = pk2(o[0], o[1]); w.y = pk2(o[2], o[3]); w.z = pk2(o[4], o[5]); w.w = pk2(o[6], o[7]);
            *(u32x4*)(ACT + (size_t)row * DFF + f) = w;
            if (t >= Tn - 2) { const int jj = t - (Tn - 2);
                float* dst = (row < NPR) ? A.out + O_CBP + ((size_t)(l * 4 + bidx) * 2 + jj) * DFF2 : A.out + O_CBS + ((size_t)(l * 128 + bidx) * 2 + jj) * DFF2;
                st8f(dst + f, hg); st8f(dst + DFF + f, hv); }
#pragma unroll
            for (int e = 0; e < 8; ++e) { g0[e] = g1[e]; g1[e] = hg[e]; v0[e] = v1[e]; v1[e] = hv[e]; }
        }
    }
}

__device__ __forceinline__ void phase_r(const Args& A, int KS, float* rsn) {
    int tid = threadIdx.x; asm volatile("" : "+v"(tid)); const int lane = tid & 63, wave = tid >> 6, G = gridDim.x;
    bf16_t* XB = WSP(bf16_t, WS_XB); const float* PART = WSP(float, WS_P);
    for (int it = blockIdx.x * 8 + wave; it < NSM * 2; it += G * 8) {
        const int rl = it >> 1, hf = it & 1, row = NPR + rl; float ss = 0.f;
#pragma unroll
        for (int j = 0; j < 4; ++j) { const int c = hf * 1024 + j * 256 + lane * 4; f32x4 x = ldp4(XB + (size_t)row * DM + c);
            for (int p = 0; p < KS; ++p) x += *(const f32x4*)(PART + ((size_t)p * NSM + rl) * DM + c);
            u32x2 w; w.x = pk2(x[0], x[1]); w.y = pk2(x[2], x[3]); *(u32x2*)(XB + (size_t)row * DM + c) = w;
            ss += (x[0] * x[0] + x[1] * x[1]) + (x[2] * x[2] + x[3] * x[3]); }
        ss = wave_sum(ss);
        if (lane == 0) unsafeAtomicAdd(rsn + row, ss);
    }
}

__device__ __forceinline__ void phase_final(const Args& A) {
    int tid = threadIdx.x; asm volatile("" : "+v"(tid)); const int lane = tid & 63, wave = tid >> 6, G = gridDim.x;
    const bf16_t* XB = WSP(bf16_t, WS_XB); const float* RS = WSP(float, WS_CTL) + 4 * TT; const float* g = A.in[34];
    for (int row = blockIdx.x * 8 + wave; row < TT; row += G * 8) {
        const float s = rsqrtf(RS[row] * (1.0f / DM) + EPS);
#pragma unroll
        for (int j = 0; j < 8; ++j) { const int c = j * 256 + lane * 4; const f32x4 v = ldp4(XB + (size_t)row * DM + c); const f32x4 gg = *(const f32x4*)(g + c);
            *(f32x4*)(A.out + (size_t)row * DM + c) = v * s * gg; }
    }
}

#define XB_TMO      128
#define XB_XCNT(j)  (256  + 64 * (j))
#define XB_XSUB(j)  (1280 + 64 * (j))
#define XB_XGEN(j)  (2304 + 64 * (j))
#define XB_TOP      3328
#define XB_TOPGEN   3392
#define XCD_BAR_WORDS 3456
#define XB_SPIN_CAP (1u << 18)

__device__ __forceinline__ unsigned xb_ld(unsigned* p)              { return __hip_atomic_load(p, __ATOMIC_RELAXED, __HIP_MEMORY_SCOPE_AGENT); }
__device__ __forceinline__ unsigned xb_add(unsigned* p, unsigned v) { return __hip_atomic_fetch_add(p, v, __ATOMIC_RELAXED, __HIP_MEMORY_SCOPE_AGENT); }
__device__ __forceinline__ unsigned xb_xcc_id() { return (unsigned)__builtin_amdgcn_s_getreg((3 << 11) | 20) & 0xFu; }
#define XB_SPIN(cond, bar) do { unsigned _sp = 0; while (cond) { __builtin_amdgcn_s_sleep(1); \
    if ((++_sp & 255u) == 0u) { if (xb_ld(&(bar)[XB_TMO])) break; if (_sp > XB_SPIN_CAP) { atomicAdd(&(bar)[XB_TMO], 1u); break; } } } } while (0)

struct XcdBarrier {
    unsigned* bar; unsigned x;
    volatile LAS unsigned* st;
};

__device__ __forceinline__ XcdBarrier xcd_barrier_post(unsigned* bar, volatile LAS unsigned* st) {
    XcdBarrier b; b.bar = bar; b.x = xb_xcc_id(); b.st = st;
    if (threadIdx.x == 0) (void)xb_add(&bar[XB_XCNT(b.x)], 1u);
    return b;
}
__device__ __forceinline__ void xcd_barrier_complete(unsigned* bar, unsigned x, unsigned& nloc, unsigned& nx) {
    const unsigned G = gridDim.x * gridDim.y * gridDim.z;
    unsigned sum, cnt, mine, sp = 0u;
    for (;;) {
        sum = 0u; cnt = 0u; mine = 0u;
#pragma unroll
        for (unsigned j = 0; j < 16; ++j) { const unsigned c = xb_ld(&bar[XB_XCNT(j)]); sum += c; cnt += (c > 0u) ? 1u : 0u; mine = (j == x) ? c : mine; }
        if (sum == G) break;
        __builtin_amdgcn_s_sleep(1);
        if ((++sp & 255u) == 0u) { if (xb_ld(&bar[XB_TMO])) break; if (sp > XB_SPIN_CAP) { atomicAdd(&bar[XB_TMO], 1u); break; } }
    }
    nloc = mine > 0u ? mine : 1u; nx = cnt > 0u ? cnt : 1u;
}

__device__ __forceinline__ void xcd_barrier(const XcdBarrier& b) {
    asm volatile("s_waitcnt vmcnt(0)" ::: "memory");
    __syncthreads();
    if (threadIdx.x == 0) {
        unsigned* bar = b.bar;
        __builtin_amdgcn_s_waitcnt(0);
        unsigned nloc = b.st[0], nx = b.st[1];
        if (nloc == 0u) { xcd_barrier_complete(bar, b.x, nloc, nx); b.st[0] = nloc; b.st[1] = nx; }
        const unsigned old = xb_add(&bar[XB_XSUB(b.x)], 1u);
        const unsigned gen = old / nloc;
        if (old + 1u == (gen + 1u) * nloc) {
            __builtin_amdgcn_fence(__ATOMIC_RELEASE, "agent");
            asm volatile("s_waitcnt vmcnt(0)" ::: "memory");
            const unsigned og = xb_add(&bar[XB_TOP], 1u);
            const unsigned tg = og / nx;
            if (og + 1u == (tg + 1u) * nx) xb_add(&bar[XB_TOPGEN], 1u);
            else XB_SPIN(xb_ld(&bar[XB_TOPGEN]) == tg, bar);
            __builtin_amdgcn_fence(__ATOMIC_ACQUIRE, "agent");
            xb_add(&bar[XB_XGEN(b.x)], 1u);
            asm volatile("s_waitcnt vmcnt(0)" ::: "memory");
        } else {
            XB_SPIN(xb_ld(&bar[XB_XGEN(b.x)]) == gen, bar);
            __builtin_amdgcn_fence(__ATOMIC_ACQUIRE, "agent");
            asm volatile("s_waitcnt vmcnt(0)" ::: "memory");
        }
    }
    __syncthreads();
}

constexpr int N_SUB = 10, N_PHASES = 2 + 2 * N_SUB;
constexpr int KS_D = 8, KS_G = 11;
__global__ void __launch_bounds__(512, 2) fwd(Args A0) {
    extern __shared__ __attribute__((aligned(16))) unsigned char lds_raw[];
    LAS unsigned char* lds = (LAS unsigned char*)lds_raw;
    cg::grid_group grid = cg::this_grid();
    const int G = gridDim.x;
    volatile LAS unsigned* MISC = (volatile LAS unsigned*)(lds + 131072 + 64);
    if (threadIdx.x < 4) MISC[threadIdx.x] = 0u;
    __syncthreads();
    XcdBarrier xbar = xcd_barrier_post((unsigned*)(A0.ws + WS_CTL + 512 * 1024), MISC);
    bool first_seam = true;
    for (int ph = A0.ph_lo; ph < A0.ph_hi; ++ph) {
        const int l = (ph - 1) / N_SUB, sub = (ph - 1) % N_SUB;
        const int dupbit = (ph == 0) ? 0 : (ph == N_PHASES - 1) ? 1 : 2 + sub;
        const int reps = 1 + ((DUP_MASK >> dupbit) & 1);
        for (int rep = 0; rep < reps; ++rep) {
        if (ph > A0.ph_lo || rep > 0) { if (first_seam) { grid.sync(); first_seam = false; } else xcd_barrier(xbar); }
        Args B = A0; { size_t z = 0; asm volatile("s_mov_b64 %0, 0" : "=s"(z)); B.ws = A0.ws + z; B.out = A0.out + z; } const Args& A = B;
        if (ph == 0) { phase_prologue(A, lds); continue; }
        if (ph == N_PHASES - 1) { phase_final(A); continue; }
        float* RS = WSP(float, WS_CTL);
        switch (sub) {
        case 0: { pg8::Gemm g{WSP(bf16_t, WS_XB), WSP(bf16_t, WS_WIN) + (size_t)l * LDP * DM, TT, LDP, DM, DM, DM}; pg8::StaticOrder S; S.init(TT, LDP, G, (int)blockIdx.x);
                  pg8::EpiP E{WSP(float, WS_P), LDP, RS + (size_t)(2 * l) * TT}; pg8::gemm_phase<pg8::EpiP, pg8::StaticOrder>(lds, g, S, E); } break;
        case 1: phase_c1(A, l, lds); break;
        case 2: phase_c2(A, l, lds); break;
        case 3: phase_c3(A, l); break;
        case 4: { { pg8::Gemm g{WSP(bf16_t, WS_MIX), WSP(bf16_t, WS_WOUT) + (size_t)l * DM * DM, NPR, DM, DM, DM, DM}; pg8::StaticOrder S; S.init(NPR, DM, G, (int)blockIdx.x);
                    pg8::EpiRes E{WSP(bf16_t, WS_XB), RS + (size_t)(2 * l + 1) * TT}; pg8::gemm_phase<pg8::EpiRes, pg8::StaticOrder>(lds, g, S, E); }
                  { pg8::Gemm g{WSP(bf16_t, WS_MIX) + (size_t)NPR * DM, WSP(bf16_t, WS_WOUT) + (size_t)l * DM * DM, NSM, DM, DM / KS_D, DM, DM}; pg8::SplitOrder S; S.init(NSM, DM, KS_D, G, (int)((blockIdx.x + 128) % G));
                    pg8::EpiPart E{WSP(float, WS_P), NSM}; pg8::gemm_phase<pg8::EpiPart, pg8::SplitOrder>(lds, g, S, E); } } break;
        case 5: phase_r(A, KS_D, RS + (size_t)(2 * l + 1) * TT); break;
        case 6: { pg8::Gemm g{WSP(bf16_t, WS_XB), WSP(bf16_t, WS_WUP) + (size_t)l * DFF2 * DM, TT, DFF2, DM, DM, DM}; pg8::StaticOrder S; S.init(TT, DFF2, G, (int)blockIdx.x);
                  pg8::EpiUp E{WSP(bf16_t, WS_HUP), DFF2, RS + (size_t)(2 * l + 1) * TT}; pg8::gemm_phase<pg8::EpiUp, pg8::StaticOrder>(lds, g, S, E); } break;
        case 7: phase_f(A, l); break;
        case 8: { { pg8::Gemm g{WSP(bf16_t, WS_ACT), WSP(bf16_t, WS_WDN) + (size_t)l * DM * DFF, NPR, DM, DFF, DFF, DFF}; pg8::StaticOrder S; S.init(NPR, DM, G, (int)blockIdx.x);
                    pg8::EpiRes E{WSP(bf16_t, WS_XB), RS + (size_t)(2 * l + 2) * TT}; pg8::gemm_phase<pg8::EpiRes, pg8::StaticOrder>(lds, g, S, E); }
                  { pg8::Gemm g{WSP(bf16_t, WS_ACT) + (size_t)NPR * DFF, WSP(bf16_t, WS_WDN) + (size_t)l * DM * DFF, NSM, DM, DFF / KS_G, DFF, DFF}; pg8::SplitOrder S; S.init(NSM, DM, KS_G, G, (int)((blockIdx.x + 128) % G));
                    pg8::EpiPart E{WSP(float, WS_P), NSM}; pg8::gemm_phase<pg8::EpiPart, pg8::SplitOrder>(lds, g, S, E); } } break;
        case 9: phase_r(A, KS_G, RS + (size_t)(2 * l + 2) * TT); break;
        }
        }
    }
}

extern "C" void kernel_launch(void* const* d_in, const int* in_sizes, int n_in, void* d_out, int out_size, void* d_ws, size_t ws_size, hipStream_t stream) {
    static int grid = 0;
    if (grid == 0) {
        if (n_in != 35 || (size_t)out_size != O_END || ws_size < WS_END) { fprintf(stderr, "kernel_launch: unexpected sizes n_in %d out %d ws %zu (need %zu)\n", n_in, out_size, ws_size, (size_t)WS_END); grid = -1; return; }
        if (hipFuncSetAttribute((const void*)fwd, hipFuncAttributeMaxDynamicSharedMemorySize, LDS_BYTES) != hipSuccess) { fprintf(stderr, "kernel_launch: hipFuncSetAttribute failed\n"); grid = -1; return; }
        int dev = 0, cus = 0, per_cu = 0;
        hipGetDevice(&dev); hipDeviceGetAttribute(&cus, hipDeviceAttributeMultiprocessorCount, dev);
        if (hipOccupancyMaxActiveBlocksPerMultiprocessor(&per_cu, (const void*)fwd, 512, LDS_BYTES) != hipSuccess || per_cu < 1) { fprintf(stderr, "kernel_launch: occupancy query failed (%d)\n", per_cu); per_cu = 1; }
        (void)hipGetLastError();
        grid = cus * per_cu;
        fprintf(stderr, "kernel_launch: grid %d (cus %d x %d)\n", grid, cus, per_cu);
    }
    if (grid < 0) return;
    (void)hipMemsetAsync((char*)d_ws + WS_CTL, 0, CTL_BYTES, stream);
    Args a{};
    for (int i = 0; i < 35; ++i) a.in[i] = (const float*)d_in[i];
    a.out = (float*)d_out; a.ws = (unsigned char*)d_ws;
#if MK_ONE_LAUNCH
    a.ph_lo = 0; a.ph_hi = N_PHASES;
    void* args[] = {&a};
    hipError_t e = hipLaunchCooperativeKernel((const void*)fwd, dim3(grid), dim3(512), args, LDS_BYTES, stream);
    if (e != hipSuccess) fprintf(stderr, "kernel_launch: cooperative launch failed: %s (grid %d)\n", hipGetErrorString(e), grid);
#else
    for (int ph = 0; ph < N_PHASES; ++ph) { a.ph_lo = ph; a.ph_hi = ph + 1; hipLaunchKernelGGL(fwd, dim3(grid), dim3(512), LDS_BYTES, stream, a); }
#endif
}
```

```cpp
#include <hip/hip_runtime.h>
#include <hip/hip_cooperative_groups.h>
#include <cstdio>
#include <cstdint>
namespace cg = cooperative_groups;

#ifndef C2_MASK
#define C2_MASK 0xFF
#endif
#ifndef DUP_MASK
#define DUP_MASK 0
#endif
#ifndef MK_ONE_LAUNCH
#define MK_ONE_LAUNCH 1
#endif

#define LAS __attribute__((address_space(3)))
typedef unsigned short bf16_t;
typedef short bf16x8 __attribute__((ext_vector_type(8)));
typedef float f32x4 __attribute__((ext_vector_type(4)));
typedef float f32x2 __attribute__((ext_vector_type(2)));
typedef unsigned u32x4 __attribute__((ext_vector_type(4)));
typedef unsigned u32x2 __attribute__((ext_vector_type(2)));

constexpr int DM = 2048, NPR = 8192, NSM = 512, TT = 8704, SEQ = 2048, DEPTH = 2;
constexpr int NIN = 6408, LDP = 6656, DFF = 5632, DFF2 = 11264;
constexpr int ML_Q = 0, ML_K = 512, ML_V = 1024, ML_O = 1536, ML_IG = 2048, ML_FG = 2052;
constexpr int RW0 = 2056, RW_R = 2056, RW_K = 3080, RW_V = 4104, RW_LW = 5128, RW_LA = 5192, RW_LG = 5256, RWC = 3328;
constexpr int SG_U = 5384, SG_V = 5896;
constexpr float EPS = 1e-6f;

constexpr size_t O_YP = 0;
constexpr size_t O_YS = O_YP + (size_t)4 * 2048 * 2048;
constexpr size_t O_CP = O_YS + (size_t)128 * 4 * 2048;
constexpr size_t O_NP = O_CP + (size_t)2 * 4 * 4 * 128 * 128;
constexpr size_t O_MP = O_NP + (size_t)2 * 4 * 4 * 128;
constexpr size_t O_SP = O_MP + (size_t)2 * 4 * 4;
constexpr size_t O_SHP = O_SP + (size_t)2 * 4 * 16 * 64 * 64;
constexpr size_t O_CBP = O_SHP + (size_t)2 * 4 * 3328;
constexpr size_t O_CS = O_CBP + (size_t)2 * 4 * 2 * 11264;
constexpr size_t O_NS = O_CS + (size_t)2 * 128 * 4 * 128 * 128;
constexpr size_t O_MS = O_NS + (size_t)2 * 128 * 4 * 128;
constexpr size_t O_SS = O_MS + (size_t)2 * 128 * 4;
constexpr size_t O_SHS = O_SS + (size_t)2 * 128 * 16 * 64 * 64;
constexpr size_t O_CBS = O_SHS + (size_t)2 * 128 * 3328;
constexpr size_t O_VS = O_CBS + (size_t)2 * 128 * 2 * 11264;
constexpr size_t O_END = O_VS + (size_t)2 * 128 * 4 * 512;

constexpr size_t MiB = 1u << 20;
constexpr size_t WS_CTL = 0, CTL_BYTES = 1 * MiB;
constexpr size_t WS_WIN = 1 * MiB;
constexpr size_t WS_WOUT = WS_WIN + 52 * MiB;
constexpr size_t WS_WUP = WS_WOUT + 16 * MiB;
constexpr size_t WS_WDN = WS_WUP + 88 * MiB;
constexpr size_t WS_X = WS_WDN + 44 * MiB;
constexpr size_t WS_XB = WS_X + 68 * MiB;
constexpr size_t WS_MIX = WS_XB + 34 * MiB;
constexpr size_t WS_P = WS_MIX + 34 * MiB;
constexpr size_t WS_ACT = WS_P + 221 * MiB;
constexpr size_t WS_HUP = WS_P;
constexpr size_t WS_Y = WS_X;
constexpr size_t WS_DEC = WS_ACT;
constexpr size_t WS_AA = WS_DEC + 34 * MiB;
constexpr size_t WS_KKN = WS_AA + 34 * MiB;
constexpr size_t WS_GG = WS_KKN + 34 * MiB;
constexpr size_t WS_HM = WS_GG + 17 * MiB;
constexpr size_t WS_GATE = WS_HM + 17 * MiB;
constexpr size_t WS_BC = WS_GATE + 1 * MiB;
constexpr size_t WS_END = WS_BC + 1 * MiB;

constexpr int LDS_BYTES = 147456;

struct Args { const float* in[35]; float* out; unsigned char* ws; int ph_lo, ph_hi; };

__device__ __forceinline__ unsigned f2bf(float f) { unsigned u = __builtin_bit_cast(unsigned, f); return (u + 0x7fffu + ((u >> 16) & 1u)) >> 16; }
__device__ __forceinline__ unsigned pk2(float lo, float hi) { return f2bf(lo) | (f2bf(hi) << 16); }
__device__ __forceinline__ float bf2f(unsigned short b) { return __builtin_bit_cast(float, ((unsigned)b) << 16); }
__device__ __forceinline__ f32x4 ldp4(const bf16_t* p) { const u32x2 w = *(const u32x2*)p; f32x4 r; r[0] = __builtin_bit_cast(float, w.x << 16); r[1] = __builtin_bit_cast(float, w.x & 0xffff0000u); r[2] = __builtin_bit_cast(float, w.y << 16); r[3] = __builtin_bit_cast(float, w.y & 0xffff0000u); return r; }
__device__ __forceinline__ unsigned cvt_pk_bf16(float lo, float hi) { unsigned r; asm volatile("v_cvt_pk_bf16_f32 %0, %1, %2" : "=v"(r) : "v"(lo), "v"(hi)); return r; }
template <int CTRL> __device__ __forceinline__ float dpp_f(float x) { return __builtin_bit_cast(float, __builtin_amdgcn_update_dpp(0, __builtin_bit_cast(int, x), CTRL, 0xf, 0xf, false)); }
__device__ __forceinline__ float row16_sum(float x) { x += dpp_f<0x128>(x); x += dpp_f<0x124>(x); x += dpp_f<0x122>(x); x += dpp_f<0x121>(x); return x; }
__device__ __forceinline__ float rlane(float x, int l) { return __builtin_bit_cast(float, __builtin_amdgcn_readlane(__builtin_bit_cast(int, x), l)); }
__device__ __forceinline__ float wave_sum(float x) { x = row16_sum(x); return (rlane(x, 0) + rlane(x, 16)) + (rlane(x, 32) + rlane(x, 48)); }
__device__ __forceinline__ float sigmoidf_(float x) { return __builtin_amdgcn_rcpf(1.0f + __expf(-x)); }
__device__ __forceinline__ float gelu_erf(float v) {
    const float av = fabsf(v), t = __builtin_amdgcn_rcpf(av * 0.2316418882f + 1.0f);
    float q = t * 0.5307027145f + (-0.7265760135f); q = q * t + 0.7107068705f; q = q * t + (-0.142248368f); q = q * t + 0.127414796f; q = q * t;
    const float e = __builtin_amdgcn_exp2f((v * v) * (-0.72134752044f));
    const float m = v * (q * e), r = v - m; return v < 0.f ? m : r; }
__device__ __forceinline__ float log1pexp_negabs(float x) { return __logf(1.0f + __expf(-fabsf(x))); }

namespace pg8 {
constexpr int BM = 256, BK = 64, HALF = 128, HTB = HALF * BK * 2, STAGE_BYTES = 8 * HTB, NXCD = 8, WGM = 8;
__host__ __device__ __forceinline__ int lds_byte(int r, int c) { const int st = (r >> 4) * 2 + (c >> 5), rr = r & 15, cc = c & 31, ob = rr * 64 + cc * 2; return st * 1024 + (ob ^ (((ob >> 9) & 1) << 5)); }
__host__ __device__ __forceinline__ void stage_rc(int b, int& R, int& C) { const int st = b / 1024, sb = b % 1024, swz = sb ^ (((sb >> 9) & 1) << 5); R = (st >> 1) * 16 + swz / 64; C = (st & 1) * 32 + (swz % 64) / 2; }
__host__ __device__ __forceinline__ int perm32(int rho) { const int n = rho >> 4, i = rho & 15; return 8 * (i >> 2) + 4 * n + (i & 3); }
struct Unit { int pm, pn, pk; };
struct Gemm { const bf16_t* A; const bf16_t* Bt; int M, N, K, lda, ldb; };
struct StaticOrder {
    int nM, nN, nwg, G, c;
    __device__ void init(int M, int N, int G_, int c_) { nM = M / BM; nN = N / BM; nwg = nM * nN; G = G_; c = c_; }
    __device__ bool next(int i, Unit& u) const {
        const long L = (long)i * G + c; if (L >= nwg) return false;
        int wgid = (int)L; { const int q = nwg / NXCD, r = nwg % NXCD, xcd = wgid % NXCD, off = wgid / NXCD; wgid = (xcd < r ? xcd * (q + 1) : r * (q + 1) + (xcd - r) * q) + off; }
        const int nig = WGM * nN, gid = wgid / nig, fm = gid * WGM, gsz = (nM - fm) < WGM ? (nM - fm) : WGM;
        u.pm = fm + ((wgid % nig) % gsz); u.pn = (wgid % nig) / gsz; u.pk = 0; return true;
    }
};
struct SplitOrder {
    int nM, nN, KS, G, c;
    __device__ void init(int M, int N, int KS_, int G_, int c_) { nM = M / BM; nN = N / BM; KS = KS_; G = G_; c = c_; }
    __device__ bool next(int i, Unit& u) const {
        const int L = i * G + c; if (L >= nM * nN * KS) return false;
        u.pk = L % KS; const int r = L / KS; u.pn = r % nN; u.pm = r / nN; return true;
    }
};
struct EpiP {
    static constexpr bool PERM = false;
    float* C; int ldc; const float* rs;
    __device__ __forceinline__ void operator()(const f32x4 (&acc)[2][2][4][2], const Unit& u, int wr, int wc, int fr, int fq) const {
        const int row0 = u.pm * BM + wr * 64 + fr, col0 = u.pn * BM + wc * 32 + 4 * fq;
#pragma unroll
        for (int ai = 0; ai < 2; ++ai)
#pragma unroll
            for (int m = 0; m < 4; ++m) { const int row = row0 + ai * HALF + m * 16; const float s = rsqrtf(rs[row] * (1.0f / DM) + EPS); float* rowp = C + (size_t)row * ldc + col0;
#pragma unroll
                for (int bj = 0; bj < 2; ++bj)
#pragma unroll
                    for (int n = 0; n < 2; ++n) *(f32x4*)(rowp + bj * HALF + n * 16) = acc[ai][bj][m][n] * s; }
    }
};
struct EpiPart {
    static constexpr bool PERM = false;
    float* C; int mloc;
    __device__ __forceinline__ void operator()(const f32x4 (&acc)[2][2][4][2], const Unit& u, int wr, int wc, int fr, int fq) const {
        const int row0 = u.pm * BM + wr * 64 + fr, col0 = u.pn * BM + wc * 32 + 4 * fq;
#pragma unroll
        for (int ai = 0; ai < 2; ++ai)
#pragma unroll
            for (int m = 0; m < 4; ++m) { const int row = row0 + ai * HALF + m * 16; float* rowp = C + ((size_t)u.pk * mloc + row) * DM + col0;
#pragma unroll
                for (int bj = 0; bj < 2; ++bj)
#pragma unroll
                    for (int n = 0; n < 2; ++n) *(f32x4*)(rowp + bj * HALF + n * 16) = acc[ai][bj][m][n]; }
    }
};
struct EpiUp {
    static constexpr bool PERM = true;
    bf16_t* O; int ldc; const float* rs;
    __device__ __forceinline__ void operator()(const f32x4 (&acc)[2][2][4][2], const Unit& u, int wr, int wc, int fr, int fq) const {
        const int row0 = u.pm * BM + wr * 64 + fr, col0 = u.pn * BM + wc * 32 + 8 * fq;
#pragma unroll
        for (int ai = 0; ai < 2; ++ai)
#pragma unroll
            for (int m = 0; m < 4; ++m) { const int row = row0 + ai * HALF + m * 16; const float s = rsqrtf(rs[row] * (1.0f / DM) + EPS); bf16_t* rowp = O + (size_t)row * ldc + col0;
#pragma unroll
                for (int bj = 0; bj < 2; ++bj) { const f32x4 v0 = acc[ai][bj][m][0] * s, v1 = acc[ai][bj][m][1] * s;
                    u32x4 w; w.x = cvt_pk_bf16(v0[0], v0[1]); w.y = cvt_pk_bf16(v0[2], v0[3]); w.z = cvt_pk_bf16(v1[0], v1[1]); w.w = cvt_pk_bf16(v1[2], v1[3]);
                    *(u32x4*)(rowp + bj * HALF) = w; } }
    }
};
struct EpiRes {
    static constexpr bool PERM = false;
    bf16_t* XB; float* rsn;
    __device__ __forceinline__ void operator()(const f32x4 (&acc)[2][2][4][2], const Unit& u, int wr, int wc, int fr, int fq) const {
        const int row0 = u.pm * BM + wr * 64 + fr, col0 = u.pn * BM + wc * 32 + 4 * fq;
#pragma unroll
        for (int ai = 0; ai < 2; ++ai)
#pragma unroll
            for (int m = 0; m < 4; ++m) { const int row = row0 + ai * HALF + m * 16; bf16_t* rowb = XB + (size_t)row * DM + col0; float ss = 0.f;
#pragma unroll
                for (int bj = 0; bj < 2; ++bj)
#pragma unroll
                    for (int n = 0; n < 2; ++n) { f32x4 x = ldp4(rowb + bj * HALF + n * 16) + acc[ai][bj][m][n];
                        u32x2 w; w.x = cvt_pk_bf16(x[0], x[1]); w.y = cvt_pk_bf16(x[2], x[3]); *(u32x2*)(rowb + bj * HALF + n * 16) = w;
                        ss += (x[0] * x[0] + x[1] * x[1]) + (x[2] * x[2] + x[3] * x[3]); }
                ss += __shfl_xor(ss, 16); ss += __shfl_xor(ss, 32);
                if (fq == 0) unsafeAtomicAdd(rsn + row, ss); }
    }
};

template <class Epi, class Sched>
__device__ __forceinline__ void gemm_phase(LAS unsigned char* lds, const Gemm g, const Sched& S, const Epi& E) {
    int tid = threadIdx.x; asm volatile("" : "+v"(tid)); const int wid = __builtin_amdgcn_readfirstlane(tid >> 6), lane = tid & 63, wr = wid >> 2, wc = wid & 3, fr = lane & 15, fq = lane >> 4;
    const int K = g.K, nt = K / BK;
    unsigned voffA[2], voffB[2];
#pragma unroll
    for (int i = 0; i < 2; ++i) { int R, C; stage_rc(tid * 16 + i * 8192, R, C); const int Rb = Epi::PERM ? ((R & ~31) + perm32(R & 31)) : R;
        voffA[i] = (unsigned)(R * g.lda + C) * 2u; voffB[i] = (unsigned)(Rb * g.ldb + C) * 2u; }
    const size_t kstep = (size_t)(BK * 2);
    const size_t hstepA = (size_t)HALF * g.lda * 2, hstepB = (size_t)HALF * g.ldb * 2;
    const size_t tstepA = 2 * hstepA, tstepB = 2 * hstepB, kofs = (size_t)K * 2;
    const unsigned ldsw = (unsigned)wid * 1024u;
    const int aoff = lds_byte(wr * 64 + fr, fq * 8), boff = lds_byte(wc * 32 + fr, fq * 8);
#define PG8_SA(b, h) (((b) * 2 + (h)) * HTB)
#define PG8_SB(b, h) ((4 + (b) * 2 + (h)) * HTB)
#define PG8_STAGE(bufoff, gbase, voff) do { _Pragma("unroll") for (int _i = 0; _i < 2; ++_i) \
        __builtin_amdgcn_global_load_lds((const unsigned*)((const char*)(gbase) + (voff)[_i]), (LAS unsigned*)(lds + (bufoff) + ldsw + _i * 8192), 16, 0, 0); } while (0)
#define PG8_LDA(dst, b, h) do { _Pragma("unroll") for (int m = 0; m < 4; ++m) _Pragma("unroll") for (int k = 0; k < 2; ++k) dst[m][k] = *(const LAS bf16x8*)(lds + PG8_SA(b, h) + aoff + m * 2048 + k * 1024); } while (0)
#define PG8_LDB(dst, b, h) do { _Pragma("unroll") for (int n = 0; n < 2; ++n) _Pragma("unroll") for (int k = 0; k < 2; ++k) dst[n][k] = *(const LAS bf16x8*)(lds + PG8_SB(b, h) + boff + n * 2048 + k * 1024); } while (0)
#define PG8_MMA(ai, bj, At, Bt) do { __builtin_amdgcn_s_setprio(1); _Pragma("unroll") for (int m = 0; m < 4; ++m) _Pragma("unroll") for (int n = 0; n < 2; ++n) _Pragma("unroll") for (int k = 0; k < 2; ++k) \
        acc[ai][bj][m][n] = __builtin_amdgcn_mfma_f32_16x16x32_bf16(Bt[n][k], At[m][k], acc[ai][bj][m][n], 0, 0, 0); __builtin_amdgcn_s_setprio(0); } while (0)
#define PG8_WAIT_V(n) asm volatile("s_waitcnt vmcnt(" #n ")" ::: "memory")
#define PG8_WAIT_L(n) asm volatile("s_waitcnt lgkmcnt(" #n ")" ::: "memory")
#define PG8_BAR __builtin_amdgcn_s_barrier()
#define PG8_SCHED __builtin_amdgcn_sched_barrier(0)
    Unit cur, nxt; int ui = 0;
    if (!S.next(0, cur)) return;
    f32x4 acc[2][2][4][2];
#pragma unroll
    for (int a = 0; a < 2; ++a)
#pragma unroll
        for (int b = 0; b < 2; ++b)
#pragma unroll
            for (int m = 0; m < 4; ++m)
#pragma unroll
                for (int n = 0; n < 2; ++n) acc[a][b][m][n] = (f32x4){0.f, 0.f, 0.f, 0.f};
    bf16x8 At[4][2], B0[2][2], B1[2][2];
    const char* cA = (const char*)g.A + (size_t)cur.pm * tstepA + (size_t)cur.pk * kofs; const char* cB = (const char*)g.Bt + (size_t)cur.pn * tstepB + (size_t)cur.pk * kofs;
    PG8_STAGE(PG8_SB(0, 0), cB, voffB); PG8_STAGE(PG8_SB(0, 1), cB + hstepB, voffB); PG8_STAGE(PG8_SA(0, 0), cA, voffA); PG8_STAGE(PG8_SA(0, 1), cA + hstepA, voffA);
    if (wr == 1) PG8_BAR;
    PG8_WAIT_V(2); PG8_BAR;
    PG8_STAGE(PG8_SB(1, 0), cB + kstep, voffB); PG8_STAGE(PG8_SA(1, 0), cA + kstep, voffA); PG8_STAGE(PG8_SB(1, 1), cB + hstepB + kstep, voffB);
    PG8_WAIT_V(6); PG8_BAR;
    for (;;) {
        const bool has_next = S.next(ui + 1, nxt);
        const char* nA = has_next ? (const char*)g.A + (size_t)nxt.pm * tstepA + (size_t)nxt.pk * kofs : cA; const char* nB = has_next ? (const char*)g.Bt + (size_t)nxt.pn * tstepB + (size_t)nxt.pk * kofs : cB;
        for (int t = 0; t < nt; t += 2) {
            const bool last = (t == nt - 2);
            const char* a1 = cA + (size_t)(t + 1) * kstep;
            const char* a2 = last ? nA : cA + (size_t)(t + 2) * kstep; const char* b2 = last ? nB : cB + (size_t)(t + 2) * kstep;
            const char* a3 = a2 + kstep; const char* b3 = b2 + kstep;
            PG8_LDB(B0, 0, 0); PG8_LDB(B1, 0, 1); PG8_SCHED; PG8_LDA(At, 0, 0); PG8_STAGE(PG8_SA(1, 1), a1 + hstepA, voffA);
            PG8_WAIT_V(8); PG8_WAIT_L(0); PG8_BAR; PG8_MMA(0, 0, At, B0); PG8_MMA(0, 1, At, B1); PG8_BAR; PG8_SCHED;
            PG8_LDA(At, 0, 1); PG8_STAGE(PG8_SB(0, 0), b2, voffB); PG8_STAGE(PG8_SB(0, 1), b2 + hstepB, voffB); PG8_STAGE(PG8_SA(0, 0), a2, voffA);
            PG8_WAIT_V(8); PG8_WAIT_L(0); PG8_BAR; PG8_MMA(1, 0, At, B0); PG8_MMA(1, 1, At, B1); PG8_BAR; PG8_SCHED;
            PG8_LDB(B0, 1, 0); PG8_LDB(B1, 1, 1); PG8_SCHED; PG8_LDA(At, 1, 0); PG8_STAGE(PG8_SA(0, 1), a2 + hstepA, voffA);
            PG8_WAIT_V(8); PG8_WAIT_L(0); PG8_BAR; PG8_MMA(0, 0, At, B0); PG8_MMA(0, 1, At, B1); PG8_BAR; PG8_SCHED;
            PG8_LDA(At, 1, 1); PG8_STAGE(PG8_SB(1, 0), b3, voffB); PG8_STAGE(PG8_SB(1, 1), b3 + hstepB, voffB); PG8_STAGE(PG8_SA(1, 0), a3, voffA);
            PG8_WAIT_V(8); PG8_WAIT_L(0); PG8_BAR; PG8_MMA(1, 0, At, B0); PG8_MMA(1, 1, At, B1); PG8_BAR; PG8_SCHED;
        }
        if (wr == 0) PG8_BAR;
        E(acc, cur, wr, wc, fr, fq);
        if (!has_next) break;
#pragma unroll
        for (int a = 0; a < 2; ++a)
#pragma unroll
            for (int b = 0; b < 2; ++b)
#pragma unroll
                for (int m = 0; m < 4; ++m)
#pragma unroll
                    for (int n = 0; n < 2; ++n) acc[a][b][m][n] = (f32x4){0.f, 0.f, 0.f, 0.f};
        cur = nxt; cA = nA; cB = nB; ++ui;
        if (wr == 1) PG8_BAR;
    }
    PG8_WAIT_V(0);
    PG8_BAR;
#undef PG8_SA
#undef PG8_SB
#undef PG8_STAGE
#undef PG8_LDA
#undef PG8_LDB
#undef PG8_MMA
#undef PG8_WAIT_V
#undef PG8_WAIT_L
#undef PG8_BAR
#undef PG8_SCHED
}
}

struct Ptrs {
    const Args* a; int l;
};
#define WSP(T, off) ((T*)(A.ws + (off)))
#define INL(i, per) (A.in[i] + (size_t)l * (per))

__device__ __forceinline__ void transpose_item(const float* W, int K, int N, int Npad, bf16_t* WT, const float* gsc, LAS float* scr, int item, int lane) {
    const int nblk = Npad / 32, kb = item / nblk, nb = item % nblk, k0 = 64 * kb, n0 = 32 * nb;
    const int n = n0 + (lane & 31);
    float tv[32];
#pragma unroll
    for (int i = 0; i < 32; ++i) { const int kk = 2 * i + (lane >> 5); tv[i] = (n < N) ? W[(size_t)(k0 + kk) * N + n] : 0.f; }
#pragma unroll
    for (int i = 0; i < 32; ++i) { const int kk = 2 * i + (lane >> 5); float v = tv[i]; if (gsc) v *= gsc[k0 + kk]; scr[kk * 33 + (lane & 31)] = v; }
    asm volatile("s_waitcnt lgkmcnt(0)" ::: "memory");
    const int c = lane & 7;
#pragma unroll
    for (int j = 0; j < 4; ++j) { const int nn = (lane >> 3) + 8 * j; const LAS float* s = scr + (8 * c) * 33 + nn;
        u32x4 o; o.x = pk2(s[0 * 33], s[1 * 33]); o.y = pk2(s[2 * 33], s[3 * 33]); o.z = pk2(s[4 * 33], s[5 * 33]); o.w = pk2(s[6 * 33], s[7 * 33]);
        *(u32x4*)(WT + (size_t)(n0 + nn) * K + k0 + 8 * c) = o; }
    asm volatile("s_waitcnt lgkmcnt(0)" ::: "memory");
}
__device__ __forceinline__ void phase_prologue(const Args& A, LAS unsigned char* lds) {
    int tid = threadIdx.x; asm volatile("" : "+v"(tid)); const int lane = tid & 63, wave = __builtin_amdgcn_readfirstlane(tid >> 6), G = gridDim.x;
    LAS float* scr = (LAS float*)(lds + wave * 16384);
    const int gw = blockIdx.x * 8 + wave, NGW = G * 8;
    constexpr int I_IN = 32 * 208, I_OUT = 32 * 64, I_UP = 32 * 352, I_DN = 88 * 64, I_L = I_IN + I_OUT + I_UP + I_DN;
    for (int it = gw; it < 2 * I_L; it += NGW) {
        const int l = it / I_L; int r = it % I_L;
        if (r < I_IN) { transpose_item(INL(9, (size_t)DM * NIN), DM, NIN, LDP, WSP(bf16_t, WS_WIN) + (size_t)l * LDP * DM, INL(8, DM), scr, r, lane); continue; } r -= I_IN;
        if (r < I_OUT) { transpose_item(INL(28, (size_t)DM * DM), DM, DM, DM, WSP(bf16_t, WS_WOUT) + (size_t)l * DM * DM, nullptr, scr, r, lane); continue; } r -= I_OUT;
        if (r < I_UP) { transpose_item(INL(30, (size_t)DM * DFF2), DM, DFF2, DFF2, WSP(bf16_t, WS_WUP) + (size_t)l * DFF2 * DM, INL(29, DM), scr, r, lane); continue; } r -= I_UP;
        transpose_item(INL(33, (size_t)DFF * DM), DFF, DM, DM, WSP(bf16_t, WS_WDN) + (size_t)l * DM * DFF, nullptr, scr, r, lane);
    }
    bf16_t* XB = WSP(bf16_t, WS_XB); float* RS = WSP(float, WS_CTL);
    for (int row = gw; row < TT; row += NGW) {
        const float* src = row < NPR ? A.in[0] + (size_t)row * DM : A.in[1] + (size_t)(row - NPR) * DM;
        float ss = 0.f;
#pragma unroll
        for (int j = 0; j < 8; ++j) { const f32x4 v = *(const f32x4*)(src + j * 256 + lane * 4);
            u32x2 w; w.x = pk2(v[0], v[1]); w.y = pk2(v[2], v[3]); *(u32x2*)(XB + (size_t)row * DM + j * 256 + lane * 4) = w;
            ss += (v[0] * v[0] + v[1] * v[1]) + (v[2] * v[2] + v[3] * v[3]); }
        ss = wave_sum(ss);
        if (lane == 0) RS[row] = ss;
    }
}

__device__ __forceinline__ f32x4 ld_prev4(const Args& A, int l, const float* P, int row, int col) {
    if (row < NPR) { if ((row & (SEQ - 1)) == 0) return (f32x4){0.f, 0.f, 0.f, 0.f}; return *(const f32x4*)(P + (size_t)(row - 1) * LDP + col); }
    const int s = row - NPR; if ((s & 3) == 0) return *(const f32x4*)(A.in[6] + ((size_t)l * 128 + (s >> 2)) * RWC + (col - RW0));
    return *(const f32x4*)(P + (size_t)(row - 1) * LDP + col);
}
__device__ __forceinline__ f32x2 ld_prev2(const Args& A, int l, const float* P, int row, int col) {
    if (row < NPR) { if ((row & (SEQ - 1)) == 0) return (f32x2){0.f, 0.f}; return *(const f32x2*)(P + (size_t)(row - 1) * LDP + col); }
    const int s = row - NPR; if ((s & 3) == 0) return *(const f32x2*)(A.in[6] + ((size_t)l * 128 + (s >> 2)) * RWC + (col - RW0));
    return *(const f32x2*)(P + (size_t)(row - 1) * LDP + col);
}
__device__ __forceinline__ float ld_prev1(const Args& A, int l, const float* P, int row, int col) {
    if (row < NPR) { if ((row & (SEQ - 1)) == 0) return 0.f; return P[(size_t)(row - 1) * LDP + col]; }
    const int s = row - NPR; if ((s & 3) == 0) return A.in[6][((size_t)l * 128 + (s >> 2)) * RWC + (col - RW0)];
    return P[(size_t)(row - 1) * LDP + col];
}

__device__ __forceinline__ void sgu_prompt(const Args& A, int l, LAS unsigned char* lds, int item);
constexpr int C1_ROWS = 34;
__device__ __forceinline__ void phase_c1(const Args& A, int l, LAS unsigned char* lds) {
    int tid = threadIdx.x; asm volatile("" : "+v"(tid)); const int lane = tid & 63, wave = tid >> 6, G = gridDim.x;
    const float* P = WSP(float, WS_P);
    const float* mu = INL(13, RWC);
    LAS float* in_s = (LAS float*)lds;
    float* DEC = WSP(float, WS_DEC); float* AAp = WSP(float, WS_AA); float* KKN = WSP(float, WS_KKN); bf16_t* GG = WSP(bf16_t, WS_GG);
    const float* w_up = INL(15, 64 * 1024); const float* a_up = INL(17, 64 * 1024); const float* g_up = INL(18, 128 * 1024);
    const int c0 = tid * 2;
    for (int tile = blockIdx.x; tile < TT / C1_ROWS; tile += G) {
        const int row0 = tile * C1_ROWS;
        __syncthreads();
        for (int idx = tid; idx < C1_ROWS * 64; idx += 512) {
            const int rr = idx >> 6, c4 = (idx & 63) * 4, row = row0 + rr;
            const f32x4 pf = *(const f32x4*)(P + (size_t)row * LDP + RW_LW + c4);
            const f32x4 pv = ld_prev4(A, l, P, row, RW_LW + c4);
            const f32x4 m4 = *(const f32x4*)(mu + (RW_LW - RW0) + c4);
            f32x4 px = pf + (pv - pf) * m4;
            if (c4 < 64) { for (int e = 0; e < 4; ++e) { const float ex = __expf(-2.0f * fabsf(px[e])); const float th = (1.0f - ex) / (1.0f + ex); px[e] = px[e] < 0.f ? -th : th; } }
            else if (c4 >= 128) { px[0] = sigmoidf_(px[0]); px[1] = sigmoidf_(px[1]); px[2] = sigmoidf_(px[2]); px[3] = sigmoidf_(px[3]); }
            *(LAS f32x4*)(in_s + rr * 256 + c4) = px;
        }
        __syncthreads();
#define C1_LORA(WPTR, NJ4, INOFF) { f32x2 wn[4]; \
            _Pragma("unroll") for (int i = 0; i < 4; ++i) wn[i] = *(const f32x2*)((WPTR) + (size_t)i * 1024 + c0); \
            for (int j4 = 0; j4 < (NJ4); ++j4) { f32x2 wv[4]; \
                _Pragma("unroll") for (int i = 0; i < 4; ++i) wv[i] = wn[i]; \
                const int jn = (j4 + 1 < (NJ4)) ? j4 + 1 : j4; \
                _Pragma("unroll") for (int i = 0; i < 4; ++i) wn[i] = *(const f32x2*)((WPTR) + (size_t)(jn * 4 + i) * 1024 + c0); \
                _Pragma("unroll") for (int t = 0; t < C1_ROWS; ++t) { const f32x4 x = *(const LAS f32x4*)(in_s + t * 256 + (INOFF) + j4 * 4); \
                    acc[t] += wv[0] * x[0]; acc[t] += wv[1] * x[1]; acc[t] += wv[2] * x[2]; acc[t] += wv[3] * x[3]; } } }
        {
            f32x2 acc[C1_ROWS];
            const f32x2 b0 = *(const f32x2*)(INL(14, 1024) + c0);
#pragma unroll
            for (int t = 0; t < C1_ROWS; ++t) acc[t] = b0;
            C1_LORA(w_up, 16, 0)
#pragma unroll
            for (int t = 0; t < C1_ROWS; ++t) { f32x2 o;
#pragma unroll
                for (int e = 0; e < 2; ++e) { const float wl = acc[t][e]; const float z = -wl; const float sp = fmaxf(z, 0.f) + log1pexp_negabs(z); const float wlog = -sp - 0.5f; o[e] = __expf(-__expf(wlog)); }
                *(f32x2*)(DEC + (size_t)(row0 + t) * 1024 + c0) = o; }
        }
        {
            f32x2 acc[C1_ROWS];
            const f32x2 b0 = *(const f32x2*)(INL(16, 1024) + c0);
#pragma unroll
            for (int t = 0; t < C1_ROWS; ++t) acc[t] = b0;
            C1_LORA(a_up, 16, 64)
#pragma unroll
            for (int t = 0; t < C1_ROWS; ++t) { f32x2 o; o[0] = sigmoidf_(acc[t][0]); o[1] = sigmoidf_(acc[t][1]); *(f32x2*)(AAp + (size_t)(row0 + t) * 1024 + c0) = o; }
        }
        {
            f32x2 acc[C1_ROWS];
#pragma unroll
            for (int t = 0; t < C1_ROWS; ++t) acc[t] = (f32x2){0.f, 0.f};
            C1_LORA(g_up, 32, 128)
#pragma unroll
            for (int t = 0; t < C1_ROWS; ++t) *(unsigned*)(GG + (size_t)(row0 + t) * 1024 + c0) = pk2(acc[t][0], acc[t][1]);
        }
#undef C1_LORA
        {
            const f32x2 kk2 = *(const f32x2*)(INL(19, 1024) + c0);
            const f32x2 mk = *(const f32x2*)(mu + (RW_K - RW0) + c0);
            for (int th = 0; th < 2; ++th) {
                f32x2 pf[17], pv[17];
#pragma unroll
                for (int t = 0; t < 17; ++t) { const int row = row0 + th * 17 + t; pf[t] = *(const f32x2*)(P + (size_t)row * LDP + RW_K + c0); pv[t] = ld_prev2(A, l, P, row, RW_K + c0); }
#pragma unroll
                for (int t = 0; t < 17; ++t) { const int row = row0 + th * 17 + t;
                    const f32x2 k = pf[t] + (pv[t] - pf[t]) * mk; f32x2 kk = k * kk2;
                    float ss = kk[0] * kk[0] + kk[1] * kk[1]; ss = row16_sum(ss); ss += __shfl_xor(ss, 16);
                    const float inv = rsqrtf(fmaxf(ss, 1e-24f));
                    *(f32x2*)(KKN + (size_t)row * 1024 + c0) = kk * inv; }
            }
        }
    }
    {
        f32x4* GATE = WSP(f32x4, WS_GATE);
        const float* b_i = INL(10, 4); const float* b_f = INL(11, 4);
        const int gw = blockIdx.x * 8 + wave, NGW = G * 8;
        for (int it = gw; it < (TT / 64) * 4; it += NGW) {
            const int h = it & 3, ch = it >> 2, row = ch * 64 + lane;
            const int segl = row < NPR ? 64 : 4;
            const float ig = P[(size_t)row * LDP + ML_IG + h] + b_i[h];
            const float fp = P[(size_t)row * LDP + ML_FG + h] + b_f[h];
            const float lf = fminf(fp, 0.f) - log1pexp_negabs(fp);
            float b = lf;
            for (int off = 1; off < segl; off <<= 1) { const float v = __shfl_up(b, off); if ((lane & (segl - 1)) >= off) b += v; }
            const float c = ig - b; float pm = c;
            for (int off = 1; off < segl; off <<= 1) { const float v = __shfl_up(pm, off); if ((lane & (segl - 1)) >= off) pm = fmaxf(pm, v); }
            GATE[(size_t)row * 4 + h] = (f32x4){c, pm, b, 0.f};
        }
    }
}

__device__ __forceinline__ float row8_sum(float x) { x += dpp_f<0xB1>(x); x += dpp_f<0x4E>(x); x += dpp_f<0x141>(x); return x; }
#define LO2(v) __builtin_shufflevector(v, v, 0, 1)
#define HI2(v) __builtin_shufflevector(v, v, 2, 3)
__device__ __forceinline__ void rwkv_prompt(const Args& A, int l, LAS unsigned char* lds, int item) {
    int tid = threadIdx.x; asm volatile("" : "+v"(tid)); const int lane = tid & 63, wave = tid >> 6;
    const int bh = item >> 1, b = bh >> 4, h = bh & 15, v0 = (item & 1) * 32, rowbase = b * SEQ;
    const int rr = lane >> 3, j = lane & 7, pi = (wave & 3) * 8 + rr, vrow = v0 + pi;
    const bool cwave = wave < 4;
    const float* P = WSP(float, WS_P);
    const float* DEC = WSP(float, WS_DEC); const float* AAp = WSP(float, WS_AA); const float* KKN = WSP(float, WS_KKN); float* Y = WSP(float, WS_Y);
    const float* mu = INL(13, RWC);
    LAS float* buf = (LAS float*)lds;
    LAS float* ybuf = buf + 2 * 6 * 32 * 64;
    constexpr int NB = SEQ / 32;
    f32x2 S0 = (f32x2){0.f, 0.f}, S1 = S0, S2 = S0, S3 = S0;
    const int pt = tid & 255, jj = pt & 15, tok0 = pt >> 4, ch = h * 64 + 4 * jj;
    const f32x4 mu_r = *(const f32x4*)(mu + (RW_R - RW0) + ch), mu_k = *(const f32x4*)(mu + (RW_K - RW0) + ch), mu_v = *(const f32x4*)(mu + (RW_V - RW0) + ch);
    const f32x4 ka = *(const f32x4*)(INL(20, 1024) + ch), rk4 = *(const f32x4*)(INL(21, 1024) + ch);
    float* BC = WSP(float, WS_BC);
    f32x4 pr[2], pk[2], pv[2], qr[2], qk[2], qv[2], dd[2], aa[2], kn[2];
#define RW_LOAD(bt) do { _Pragma("unroll") for (int u_ = 0; u_ < 2; ++u_) { const int row_ = rowbase + (bt) * 32 + tok0 + 16 * u_; \
        pr[u_] = *(const f32x4*)(P + (size_t)row_ * LDP + RW_R + ch); pk[u_] = *(const f32x4*)(P + (size_t)row_ * LDP + RW_K + ch); pv[u_] = *(const f32x4*)(P + (size_t)row_ * LDP + RW_V + ch); \
        qr[u_] = ld_prev4(A, l, P, row_, RW_R + ch); qk[u_] = ld_prev4(A, l, P, row_, RW_K + ch); qv[u_] = ld_prev4(A, l, P, row_, RW_V + ch); \
        dd[u_] = *(const f32x4*)(DEC + (size_t)row_ * 1024 + ch); aa[u_] = *(const f32x4*)(AAp + (size_t)row_ * 1024 + ch); kn[u_] = *(const f32x4*)(KKN + (size_t)row_ * 1024 + ch); } } while (0)
#define RW_STAGE(bt) do { LAS float* bw_ = buf + ((bt) & 1) * (6 * 32 * 64); _Pragma("unroll") for (int u_ = 0; u_ < 2; ++u_) { const int tok_ = tok0 + 16 * u_; \
        const f32x4 r_ = pr[u_] + (qr[u_] - pr[u_]) * mu_r, k_ = pk[u_] + (qk[u_] - pk[u_]) * mu_k, v_ = pv[u_] + (qv[u_] - pv[u_]) * mu_v; \
        const f32x4 k2_ = k_ * (1.0f + (aa[u_] - 1.0f) * ka); \
        { const f32x4 t3_ = r_ * k2_ * rk4; const float bc_ = row16_sum((t3_[0] + t3_[1]) + (t3_[2] + t3_[3])); if (jj == 0 && (item & 1) == 0) BC[(size_t)(rowbase + (bt) * 32 + tok_) * 16 + h] = bc_; } \
        *(LAS f32x4*)(bw_ + (0 * 32 + tok_) * 64 + 4 * jj) = dd[u_]; *(LAS f32x4*)(bw_ + (1 * 32 + tok_) * 64 + 4 * jj) = -kn[u_]; *(LAS f32x4*)(bw_ + (2 * 32 + tok_) * 64 + 4 * jj) = kn[u_] * aa[u_]; \
        *(LAS f32x4*)(bw_ + (3 * 32 + tok_) * 64 + 4 * jj) = k2_; *(LAS f32x4*)(bw_ + (4 * 32 + tok_) * 64 + 4 * jj) = r_; *(LAS f32x4*)(bw_ + (5 * 32 + tok_) * 64 + 4 * jj) = v_; } } while (0)
#define RW_FLUSH(btx) do { _Pragma("unroll") for (int u_ = 0; u_ < 2; ++u_) { const int i_ = pt + 256 * u_, s_ = i_ >> 4, c2_ = (i_ & 15) * 2; const f32x2 yv_ = *(const LAS f32x2*)(ybuf + ((btx) & 1) * 1024 + s_ * 32 + c2_); \
        *(f32x2*)(Y + (size_t)(rowbase + (btx) * 32 + s_) * 1024 + h * 64 + v0 + c2_) = yv_; } } while (0)
    __syncthreads();
    if (!cwave) { RW_LOAD(0); RW_STAGE(0); RW_LOAD(1); }
    __syncthreads();
    for (int bt = 0; bt < NB; ++bt) {
        if (cwave) {
            const LAS float* bb = buf + (bt & 1) * (6 * 32 * 64);
            LAS float* yb = ybuf + (bt & 1) * 1024;
            const LAS float* bj = bb + 8 * j;
            const LAS float* bv = bb + (5 * 32) * 64 + vrow;
#define RW_LD8(vec, st, lo, hi) const f32x4 lo = *(const LAS f32x4*)(bj + ((vec) * 32 + (st)) * 64), hi = *(const LAS f32x4*)(bj + ((vec) * 32 + (st)) * 64 + 4)
            f32x4 cw0, cw1, ca0, ca1, cb0, cb1, ck0, ck1, cr0, cr1; float cv;
            { RW_LD8(0, 0, a_, b_); cw0 = a_; cw1 = b_; } { RW_LD8(1, 0, a_, b_); ca0 = a_; ca1 = b_; } { RW_LD8(2, 0, a_, b_); cb0 = a_; cb1 = b_; }
            { RW_LD8(3, 0, a_, b_); ck0 = a_; ck1 = b_; } { RW_LD8(4, 0, a_, b_); cr0 = a_; cr1 = b_; } cv = bv[0];
#pragma unroll 8
            for (int s = 0; s < 32; ++s) {
                const int sn = (s + 1) & 31;
                RW_LD8(0, sn, nw0, nw1); RW_LD8(1, sn, na0, na1); RW_LD8(2, sn, nb0, nb1); RW_LD8(3, sn, nk0, nk1); RW_LD8(4, sn, nr0, nr1); const float nv = bv[sn * 64];
                f32x2 t2 = S0 * LO2(ca0); t2 += S1 * HI2(ca0); t2 += S2 * LO2(ca1); t2 += S3 * HI2(ca1);
                const float sa = row8_sum(t2[0] + t2[1]);
                S0 = S0 * LO2(cw0) + LO2(ck0) * cv; S1 = S1 * HI2(cw0) + HI2(ck0) * cv; S2 = S2 * LO2(cw1) + LO2(ck1) * cv; S3 = S3 * HI2(cw1) + HI2(ck1) * cv;
                S0 += LO2(cb0) * sa; S1 += HI2(cb0) * sa; S2 += LO2(cb1) * sa; S3 += HI2(cb1) * sa;
                f32x2 u2 = S0 * LO2(cr0); u2 += S1 * HI2(cr0); u2 += S2 * LO2(cr1); u2 += S3 * HI2(cr1);
                const float y = row8_sum(u2[0] + u2[1]);
                yb[s * 32 + pi] = y;
                cw0 = nw0; cw1 = nw1; ca0 = na0; ca1 = na1; cb0 = nb0; cb1 = nb1; ck0 = nk0; ck1 = nk1; cr0 = nr0; cr1 = nr1; cv = nv;
            }
#undef RW_LD8
        } else {
            if (bt + 1 < NB) RW_STAGE(bt + 1);
            if (bt + 2 < NB) RW_LOAD(bt + 2);
            if (bt > 0) RW_FLUSH(bt - 1);
        }
        __syncthreads();
    }
    if (!cwave) RW_FLUSH(NB - 1);
#undef RW_LOAD
#undef RW_STAGE
#undef RW_FLUSH
    if (cwave) {
        float* So = A.out + O_SP + (size_t)((l * 4 + b) * 16 + h) * 64 * 64 + (size_t)vrow * 64 + 8 * j;
        *(f32x4*)(So) = (f32x4){S0[0], S0[1], S1[0], S1[1]};
        *(f32x4*)(So + 4) = (f32x4){S2[0], S2[1], S3[0], S3[1]};
    }
    __syncthreads();
}
__device__ __forceinline__ void rwkv_sample2(const Args& A, int l, LAS unsigned char* lds, int item) {
    int tid = threadIdx.x; asm volatile("" : "+v"(tid)); const int lane = tid & 63, wave = tid >> 6;
    const int b = item >> 3, h0 = (item & 7) * 2, rowbase = NPR + b * 4;
    const int rr = lane >> 4, j = lane & 15;
    const float* P = WSP(float, WS_P);
    const float* DEC = WSP(float, WS_DEC); const float* AAp = WSP(float, WS_AA); const float* KKN = WSP(float, WS_KKN); float* Y = WSP(float, WS_Y);
    const float* mu = INL(13, RWC);
    LAS float* buf = (LAS float*)lds;
    const float* S0 = A.in[5] + (size_t)((l * 128 + b) * 16 + h0) * 64 * 64;
    float* So = A.out + O_SS + (size_t)((l * 128 + b) * 16 + h0) * 64 * 64;
    f32x4 S[4];
#pragma unroll
    for (int q = 0; q < 4; ++q) { const int vrow = (q & 1) * 32 + wave * 4 + rr; S[q] = *(const f32x4*)(S0 + (size_t)(q >> 1) * 4096 + (size_t)vrow * 64 + 4 * j); }
    if (tid < 128) {
        const int hd = tid >> 6, tok = (tid >> 4) & 3, jj = tid & 15, ch = (h0 + hd) * 64 + 4 * jj, row = rowbase + tok;
        const f32x4 mu_r = *(const f32x4*)(mu + (RW_R - RW0) + ch), mu_k = *(const f32x4*)(mu + (RW_K - RW0) + ch), mu_v = *(const f32x4*)(mu + (RW_V - RW0) + ch);
        const f32x4 ka = *(const f32x4*)(INL(20, 1024) + ch);
        const f32x4 pr = *(const f32x4*)(P + (size_t)row * LDP + RW_R + ch), pk = *(const f32x4*)(P + (size_t)row * LDP + RW_K + ch), pv = *(const f32x4*)(P + (size_t)row * LDP + RW_V + ch);
        const f32x4 qr = ld_prev4(A, l, P, row, RW_R + ch), qk = ld_prev4(A, l, P, row, RW_K + ch), qv = ld_prev4(A, l, P, row, RW_V + ch);
        const f32x4 dd = *(const f32x4*)(DEC + (size_t)row * 1024 + ch), aa = *(const f32x4*)(AAp + (size_t)row * 1024 + ch), kn = *(const f32x4*)(KKN + (size_t)row * 1024 + ch);
        const f32x4 r = pr + (qr - pr) * mu_r, k = pk + (qk - pk) * mu_k, v = pv + (qv - pv) * mu_v;
        const f32x4 k2 = k * (1.0f + (aa - 1.0f) * ka);
        { const f32x4 t3 = r * k2 * *(const f32x4*)(INL(21, 1024) + ch); const float bc = row16_sum((t3[0] + t3[1]) + (t3[2] + t3[3])); if (jj == 0) WSP(float, WS_BC)[(size_t)row * 16 + h0 + hd] = bc; }
        LAS float* bb = buf + hd * (6 * 4 * 64);
        *(LAS f32x4*)(bb + (0 * 4 + tok) * 64 + 4 * jj) = dd;
        *(LAS f32x4*)(bb + (1 * 4 + tok) * 64 + 4 * jj) = -kn;
        *(LAS f32x4*)(bb + (2 * 4 + tok) * 64 + 4 * jj) = kn * aa;
        *(LAS f32x4*)(bb + (3 * 4 + tok) * 64 + 4 * jj) = k2;
        *(LAS f32x4*)(bb + (4 * 4 + tok) * 64 + 4 * jj) = r;
        *(LAS f32x4*)(bb + (5 * 4 + tok) * 64 + 4 * jj) = v;
    }
    __syncthreads();
#pragma unroll
    for (int t = 0; t < 4; ++t) {
#pragma unroll
        for (int q = 0; q < 4; ++q) { const int hd = q >> 1, vrow = (q & 1) * 32 + wave * 4 + rr; const LAS float* bb = buf + hd * (6 * 4 * 64);
            const f32x4 w4 = *(const LAS f32x4*)(bb + (0 * 4 + t) * 64 + 4 * j), a4 = *(const LAS f32x4*)(bb + (1 * 4 + t) * 64 + 4 * j), b4 = *(const LAS f32x4*)(bb + (2 * 4 + t) * 64 + 4 * j),
                        k4 = *(const LAS f32x4*)(bb + (3 * 4 + t) * 64 + 4 * j), r4 = *(const LAS f32x4*)(bb + (4 * 4 + t) * 64 + 4 * j); const float vv = bb[(5 * 4 + t) * 64 + vrow];
            float sa = (S[q][0] * a4[0] + S[q][1] * a4[1]) + (S[q][2] * a4[2] + S[q][3] * a4[3]);
            sa = row16_sum(sa);
            S[q] = S[q] * w4 + k4 * vv;
            S[q] = S[q] + b4 * sa;
            float y = (S[q][0] * r4[0] + S[q][1] * r4[1]) + (S[q][2] * r4[2] + S[q][3] * r4[3]);
            y = row16_sum(y);
            if (j == 0) Y[(size_t)(rowbase + t) * 1024 + (h0 + hd) * 64 + vrow] = y; }
    }
#pragma unroll
    for (int q = 0; q < 4; ++q) { const int vrow = (q & 1) * 32 + wave * 4 + rr; *(f32x4*)(So + (size_t)(q >> 1) * 4096 + (size_t)vrow * 64 + 4 * j) = S[q]; }
    __syncthreads();
}

__device__ __forceinline__ void mlstm_prompt(const Args& A, int l, LAS unsigned char* lds, int bh, int half) {
    int tid = threadIdx.x; asm volatile("" : "+v"(tid)); const int lane = tid & 63, wave = __builtin_amdgcn_readfirstlane(tid >> 6), fr = lane & 15, fq = lane >> 4;
    const int b = bh >> 2, h = bh & 3, eo = half * 4;
    const float* P = WSP(float, WS_P); const f32x4* GATE = WSP(f32x4, WS_GATE); float* HM = WSP(float, WS_HM);
    LAS bf16_t* Qs = (LAS bf16_t*)(lds);
    LAS bf16_t* Ks = (LAS bf16_t*)(lds + 17408);
    LAS bf16_t* Vt = (LAS bf16_t*)(lds + 34816);
    LAS bf16_t* Kwt = (LAS bf16_t*)(lds + 55552);
    LAS bf16_t* Ct = (LAS bf16_t*)(lds + 73984);
    LAS bf16_t* Att = (LAS bf16_t*)(lds + 113152);
    LAS float* gf = (LAS float*)(lds + 122368);
    LAS float *cs = gf, *Mt = gf + 64, *si = gf + 128, *fl = gf + 192, *den = gf + 256, *wk = gf + 320, *misc = gf + 384;
    __syncthreads();
    for (int i = tid; i < 144 * 136 / 2; i += 512) ((LAS unsigned*)Ct)[i] = 0u;
    for (int i = tid; i < 64 * 72 / 2; i += 512) ((LAS unsigned*)Att)[i] = 0u;
    for (int i = tid; i < 16 * 72; i += 512) Vt[64 * 72 + i] = (i < 64) ? (bf16_t)0x3F80 : (bf16_t)0;
    f32x4 cacc[5];
#pragma unroll
    for (int e = 0; e < 5; ++e) cacc[e] = (f32x4){0.f, 0.f, 0.f, 0.f};
    float m = 0.f;
    const float kscale = 0.08838834764831845f;
    f32x4 nq[4], nk[4], nv[4]; f32x4 gnx = (f32x4){0.f, 0.f, 0.f, 0.f};
#define ML_SWZ(r, cchunk) ((((cchunk) ^ (((r) >> 2) & 7))) << 3)
#define ML_LOAD(c) do { if (tid < 64) gnx = GATE[(size_t)(b * SEQ + (c) * 64 + tid) * 4 + h];  const int row0_ = b * SEQ + (c) * 64; _Pragma("unroll") for (int i = 0; i < 4; ++i) { const int idx = tid + i * 512, t = idx >> 5, d4 = (idx & 31) * 4; const float* pp = P + (size_t)(row0_ + t) * LDP + h * 128 + d4; \
        nq[i] = *(const f32x4*)(pp + ML_Q); nk[i] = *(const f32x4*)(pp + ML_K); nv[i] = *(const f32x4*)(pp + ML_V); } } while (0)
    ML_LOAD(0);
    __syncthreads();
    for (int c = 0; c < 32; ++c) {
        const int row0 = b * SEQ + c * 64;
        if (tid < 64) {
            const f32x4 g = gnx;
            const float M = fmaxf(m, g[1]);
            cs[tid] = g[0]; Mt[tid] = M; si[tid] = __expf(m - M); fl[tid] = __expf(-(g[2] + M));
            const float M63 = rlane(M, 63), b63 = rlane(g[2], 63);
            wk[tid] = __expf(g[0] - M63);
            if (tid == 0) misc[0] = b63 + M63;
        }
        __syncthreads();
        m = misc[0];
#pragma unroll
        for (int i = 0; i < 4; ++i) { const int idx = tid + i * 512, t = idx >> 5, d4 = (idx & 31) * 4; const float w = wk[t];
            u32x2 q2; q2.x = pk2(nq[i][0], nq[i][1]); q2.y = pk2(nq[i][2], nq[i][3]); *(LAS u32x2*)(Qs + t * 136 + d4) = q2;
            const f32x4 ks = nk[i] * kscale;
            u32x2 k2; k2.x = pk2(ks[0], ks[1]); k2.y = pk2(ks[2], ks[3]); *(LAS u32x2*)(Ks + t * 136 + d4) = k2;
#pragma unroll
            for (int e = 0; e < 4; ++e) { const int sw = (d4 + e) * 72 + ML_SWZ(d4 + e, t >> 3) + (t & 7); Kwt[sw] = (bf16_t)f2bf(ks[e] * w);
                if ((d4 >> 6) == half) { const int rl_ = (d4 & 63) + e; Vt[rl_ * 72 + ML_SWZ(rl_, t >> 3) + (t & 7)] = (bf16_t)f2bf(nv[i][e]); } } }
        __syncthreads();
        if (c + 1 < 32) ML_LOAD(c + 1);
        for (int tl = wave; tl < 10; tl += 8) {
            int ti, sj; if (tl < 1) { ti = 0; sj = 0; } else if (tl < 3) { ti = 1; sj = tl - 1; } else if (tl < 6) { ti = 2; sj = tl - 3; } else { ti = 3; sj = tl - 6; }
            f32x4 acc = (f32x4){0.f, 0.f, 0.f, 0.f};
#pragma unroll
            for (int ks = 0; ks < 4; ++ks) { const bf16x8 a = *(const LAS bf16x8*)(Qs + (ti * 16 + fr) * 136 + ks * 32 + fq * 8); const bf16x8 bb = *(const LAS bf16x8*)(Ks + (sj * 16 + fr) * 136 + ks * 32 + fq * 8);
                acc = __builtin_amdgcn_mfma_f32_16x16x32_bf16(a, bb, acc, 0, 0, 0); }
            const int s = sj * 16 + fr; const float csv = cs[s];
#pragma unroll
            for (int jx = 0; jx < 4; ++jx) { const int t = ti * 16 + fq * 4 + jx; const float v = (s <= t) ? acc[jx] * __expf(csv - Mt[t]) : 0.f; Att[t * 72 + s] = (bf16_t)f2bf(v); }
        }
        __syncthreads();
        const int ti = wave & 3, e0 = (wave >> 2) ? 3 : 0, e1 = (wave >> 2) ? 5 : 3;
        f32x4 o[3];
        {
            bf16x8 qa[4], aa2[2];
#pragma unroll
            for (int ks = 0; ks < 4; ++ks) qa[ks] = *(const LAS bf16x8*)(Qs + (ti * 16 + fr) * 136 + ks * 32 + fq * 8);
#pragma unroll
            for (int ks = 0; ks < 2; ++ks) aa2[ks] = *(const LAS bf16x8*)(Att + (ti * 16 + fr) * 72 + ks * 32 + fq * 8);
            float sv[4];
#pragma unroll
            for (int jx = 0; jx < 4; ++jx) sv[jx] = si[ti * 16 + fq * 4 + jx];
#pragma unroll
            for (int ei = 0; ei < 3; ++ei) { const int et = e0 + ei; if (et < e1) {
                f32x4 acc = (f32x4){0.f, 0.f, 0.f, 0.f};
#pragma unroll
                for (int ks = 0; ks < 4; ++ks) { const bf16x8 bb = *(const LAS bf16x8*)(Ct + (et * 16 + fr) * 136 + ks * 32 + fq * 8); acc = __builtin_amdgcn_mfma_f32_16x16x32_bf16(qa[ks], bb, acc, 0, 0, 0); }
#pragma unroll
                for (int jx = 0; jx < 4; ++jx) acc[jx] *= sv[jx];
#pragma unroll
                for (int ks = 0; ks < 2; ++ks) { const bf16x8 bb = *(const LAS bf16x8*)(Vt + (et * 16 + fr) * 72 + ML_SWZ(et * 16 + fr, ks * 4 + fq)); acc = __builtin_amdgcn_mfma_f32_16x16x32_bf16(aa2[ks], bb, acc, 0, 0, 0); }
                o[ei] = acc;
                if (et == 4 && fr == 0) {
#pragma unroll
                    for (int jx = 0; jx < 4; ++jx) den[ti * 16 + fq * 4 + jx] = acc[jx]; }
            } }
        }
        __syncthreads();
        {
            float dn[4];
#pragma unroll
            for (int jx = 0; jx < 4; ++jx) { const int t = ti * 16 + fq * 4 + jx; dn[jx] = 1.0f / fmaxf(fabsf(den[t]), fl[t]); }
#pragma unroll
            for (int ei = 0; ei < 3; ++ei) { const int et = e0 + ei; if (et < e1 && et < 4) {
#pragma unroll
                for (int jx = 0; jx < 4; ++jx) { const int t = ti * 16 + fq * 4 + jx; HM[(size_t)(row0 + t) * 512 + h * 128 + (eo + et) * 16 + fr] = o[ei][jx] * dn[jx]; } } }
        }
        {
            const float dec = si[63];
            bf16x8 kb[2];
#pragma unroll
            for (int ks = 0; ks < 2; ++ks) kb[ks] = *(const LAS bf16x8*)(Kwt + (wave * 16 + fr) * 72 + ML_SWZ(wave * 16 + fr, ks * 4 + fq));
#pragma unroll
            for (int et = 0; et < 5; ++et) { f32x4 acc = cacc[et] * dec;
#pragma unroll
                for (int ks = 0; ks < 2; ++ks) { const bf16x8 va = *(const LAS bf16x8*)(Vt + (et * 16 + fr) * 72 + ML_SWZ(et * 16 + fr, ks * 4 + fq)); acc = __builtin_amdgcn_mfma_f32_16x16x32_bf16(va, kb[ks], acc, 0, 0, 0); }
                cacc[et] = acc;
#pragma unroll
                for (int jx = 0; jx < 4; ++jx) Ct[(et * 16 + fq * 4 + jx) * 136 + wave * 16 + fr] = (bf16_t)f2bf(acc[jx]); }
        }
        __syncthreads();
    }
#undef ML_LOAD
#undef ML_SWZ
    {
        float* Co = A.out + O_CP + (size_t)((l * 4 + b) * 4 + h) * 128 * 128;
        const int d = wave * 16 + fr;
#pragma unroll
        for (int et = 0; et < 4; ++et) *(f32x4*)(Co + (size_t)d * 128 + (eo + et) * 16 + fq * 4) = cacc[et];
        if (fq == 0 && half == 0) A.out[O_NP + (size_t)((l * 4 + b) * 4 + h) * 128 + d] = cacc[4][0];
        if (tid == 0 && half == 0) A.out[O_MP + (l * 4 + b) * 4 + h] = m;
    }
    __syncthreads();
}

__device__ __forceinline__ void mlstm_sample(const Args& A, int l, LAS unsigned char* lds, int item) {
    int tid = threadIdx.x; asm volatile("" : "+v"(tid)); const int lane = tid & 63, wave = tid >> 6;
    const int b = item >> 2, h = item & 3, row0 = NPR + b * 4;
    const float* P = WSP(float, WS_P); const f32x4* GATE = WSP(f32x4, WS_GATE); float* HM = WSP(float, WS_HM);
    LAS float* q = (LAS float*)lds;
    LAS float* k = q + 512;
    LAS float* v = k + 512;
    LAS float* att = v + 512;
    LAS float* gv = att + 16;
    LAS float* qn = gv + 32;
    LAS float* qc = qn + 32;
    const float* C0 = A.in[2] + (size_t)((l * 128 + b) * 4 + h) * 128 * 128;
    const float* n0 = A.in[3] + (size_t)((l * 128 + b) * 4 + h) * 128;
    const float m0 = A.in[4][(l * 128 + b) * 4 + h];
    const int rg = tid >> 5, e4 = (tid & 31) * 4;
    f32x4 cv[8];
#pragma unroll
    for (int p = 0; p < 8; ++p) cv[p] = *(const f32x4*)(C0 + (size_t)(p * 16 + rg) * 128 + e4);
    __syncthreads();
    { const int t = tid >> 7, d = tid & 127; const float* pp = P + (size_t)(row0 + t) * LDP + h * 128 + d;
      q[tid] = pp[ML_Q]; k[tid] = pp[ML_K] * 0.08838834764831845f; v[tid] = pp[ML_V]; }
    if (tid < 4) {
        const f32x4 g = GATE[(size_t)(row0 + tid) * 4 + h]; const float M = fmaxf(m0, g[1]);
        gv[tid] = __expf(m0 - M); gv[4 + tid] = __expf(-(g[2] + M)); gv[12 + tid] = g[0]; gv[16 + tid] = M;
        const float M3 = rlane(M, 3), b3 = rlane(g[2], 3);
        gv[8 + tid] = __expf(g[0] - M3);
        if (tid == 0) { gv[20] = __expf(m0 - M3); gv[21] = b3 + M3; }
    }
    __syncthreads();
    for (int pr = wave; pr < 16; pr += 8) { const int t = pr >> 2, s2 = pr & 3;
        float d = q[t * 128 + lane] * k[s2 * 128 + lane] + q[t * 128 + 64 + lane] * k[s2 * 128 + 64 + lane]; d = wave_sum(d);
        if (lane == 0) att[pr] = (s2 <= t) ? d * __expf(gv[12 + s2] - gv[16 + t]) : 0.f; }
    const float dec = gv[20];
    f32x4 v4[4]; float wkv[4];
#pragma unroll
    for (int s2 = 0; s2 < 4; ++s2) { wkv[s2] = gv[8 + s2]; v4[s2] = *(const LAS f32x4*)(v + s2 * 128 + e4); }
    f32x4 acc[4];
#pragma unroll
    for (int t = 0; t < 4; ++t) acc[t] = (f32x4){0.f, 0.f, 0.f, 0.f};
    float* Co = A.out + O_CS + (size_t)((l * 128 + b) * 4 + h) * 128 * 128;
#pragma unroll
    for (int p = 0; p < 8; ++p) { const int d = p * 16 + rg; f32x4 cn = cv[p] * dec;
#pragma unroll
        for (int s2 = 0; s2 < 4; ++s2) { acc[s2] += cv[p] * q[s2 * 128 + d]; cn += v4[s2] * (wkv[s2] * k[s2 * 128 + d]); }
        *(f32x4*)(Co + (size_t)d * 128 + e4) = cn; }
#pragma unroll
    for (int t = 0; t < 4; ++t) *(LAS f32x4*)(qc + (rg * 4 + t) * 128 + e4) = acc[t];
    if (tid < 128) { const float nv0 = n0[tid]; float nn = dec * nv0;
#pragma unroll
        for (int s2 = 0; s2 < 4; ++s2) nn += wkv[s2] * k[s2 * 128 + tid];
        A.out[O_NS + (size_t)((l * 128 + b) * 4 + h) * 128 + tid] = nn;
#pragma unroll
        for (int t = 0; t < 4; ++t) { float pq = q[t * 128 + tid] * nv0; pq = wave_sum(pq); if (lane == 0) qn[wave * 4 + t] = pq; } }
    if (tid == 0) A.out[O_MS + (l * 128 + b) * 4 + h] = gv[21];
    __syncthreads();
    { const int t = tid >> 7, e = tid & 127; const float sit = gv[t];
      float qs = 0.f;
#pragma unroll
      for (int r2 = 0; r2 < 16; ++r2) qs += qc[(r2 * 4 + t) * 128 + e];
      float num = sit * qs;
      float dn = sit * (qn[t] + qn[4 + t]);
#pragma unroll
      for (int s2 = 0; s2 < 4; ++s2) { const float a = att[t * 4 + s2]; num += a * v[s2 * 128 + e]; dn += a; }
      HM[(size_t)(row0 + t) * 512 + h * 128 + e] = num / fmaxf(fabsf(dn), gv[4 + t]); }
    __syncthreads();
}

__device__ __forceinline__ void sgu_prompt(const Args& A, int l, LAS unsigned char* lds, int item) {
    int tid = threadIdx.x; asm volatile("" : "+v"(tid));
    const int g = item & 3, chn = item >> 2, r0 = chn * 128;
    const float* P = WSP(float, WS_P); bf16_t* MIX = WSP(bf16_t, WS_MIX);
    LAS float* vn = (LAS float*)lds;
    LAS float* Wt = vn + 128 * 128;
    const float* Wg = INL(26, 4 * 128 * 128) + (size_t)g * 128 * 128;
    __syncthreads();
    { const int s = tid >> 2, qd = tid & 3; const float* pp = P + (size_t)(r0 + s) * LDP + SG_V + g * 128 + qd * 32;
      f32x4 z[8]; float sm = 0.f;
#pragma unroll
      for (int i = 0; i < 8; ++i) { z[i] = *(const f32x4*)(pp + 4 * i);
#pragma unroll
          for (int e = 0; e < 4; ++e) { z[i][e] = gelu_erf(z[i][e]); sm += z[i][e]; } }
      sm += __shfl_xor(sm, 1); sm += __shfl_xor(sm, 2); const float mean = sm * (1.0f / 128.0f); float sq = 0.f;
#pragma unroll
      for (int i = 0; i < 8; ++i)
#pragma unroll
          for (int e = 0; e < 4; ++e) { z[i][e] -= mean; sq += z[i][e] * z[i][e]; }
      sq += __shfl_xor(sq, 1); sq += __shfl_xor(sq, 2); const float rstd = rsqrtf(sq * (1.0f / 128.0f) + EPS);
      const float* lg = INL(24, 512) + g * 128 + qd * 32; const float* lb = INL(25, 512) + g * 128 + qd * 32;
#pragma unroll
      for (int i = 0; i < 8; ++i) { const f32x4 gg = *(const f32x4*)(lg + 4 * i), bb = *(const f32x4*)(lb + 4 * i); *(LAS f32x4*)(vn + s * 128 + qd * 32 + 4 * i) = z[i] * rstd * gg + bb; } }
    for (int idx = tid; idx < 128 * 32; idx += 512) { const int t = idx & 127, s4 = (idx >> 7) * 4; const f32x4 w = *(const f32x4*)(Wg + (size_t)t * 128 + s4);
#pragma unroll
        for (int e = 0; e < 4; ++e) Wt[(s4 + e) * 128 + t] = (s4 + e <= t) ? w[e] : 0.f; }
    __syncthreads();
    const int d = tid & 127, tq = tid >> 7, t0 = tq * 32;
    float acc[32];
#pragma unroll
    for (int i = 0; i < 32; ++i) acc[i] = 0.f;
    for (int s = 0; s < t0 + 32; ++s) { const float x = vn[s * 128 + d];
#pragma unroll
        for (int i4 = 0; i4 < 8; ++i4) { const f32x4 w = *(const LAS f32x4*)(Wt + s * 128 + t0 + 4 * i4);
#pragma unroll
            for (int e = 0; e < 4; ++e) acc[i4 * 4 + e] += w[e] * x; } }
    const float* bs = INL(27, 512) + g * 128;
#pragma unroll 4
    for (int i = 0; i < 32; ++i) { const int t = t0 + i; const float u = gelu_erf(P[(size_t)(r0 + t) * LDP + SG_U + g * 128 + d]);
        MIX[(size_t)(r0 + t) * DM + 1536 + g * 128 + d] = (bf16_t)f2bf(u * (acc[i] + bs[t])); }
    __syncthreads();
}
__device__ __forceinline__ void sgu_sample(const Args& A, int l, LAS unsigned char* lds, int b) {
    int tid = threadIdx.x; asm volatile("" : "+v"(tid)); const int lane = tid & 63, wave = tid >> 6, g = tid >> 7, r0 = NPR + b * 4;
    const float* P = WSP(float, WS_P); bf16_t* MIX = WSP(bf16_t, WS_MIX);
    LAS float* ex = (LAS float*)lds;
    float z[4];
    __syncthreads();
#pragma unroll
    for (int t = 0; t < 4; ++t) { z[t] = gelu_erf(P[(size_t)(r0 + t) * LDP + SG_V + tid]); const float s = wave_sum(z[t]); if (lane == 0) ex[wave * 4 + t] = s; }
    __syncthreads();
    float mean[4];
#pragma unroll
    for (int t = 0; t < 4; ++t) mean[t] = (ex[(2 * g) * 4 + t] + ex[(2 * g + 1) * 4 + t]) * (1.0f / 128.0f);
    __syncthreads();
#pragma unroll
    for (int t = 0; t < 4; ++t) { z[t] -= mean[t]; const float s = wave_sum(z[t] * z[t]); if (lane == 0) ex[wave * 4 + t] = s; }
    __syncthreads();
    const float lg = INL(24, 512)[tid], lb = INL(25, 512)[tid];
    float vnr[4];
#pragma unroll
    for (int t = 0; t < 4; ++t) { const float var = (ex[(2 * g) * 4 + t] + ex[(2 * g + 1) * 4 + t]) * (1.0f / 128.0f); vnr[t] = z[t] * rsqrtf(var + EPS) * lg + lb;
        A.out[O_VS + ((size_t)(l * 128 + b) * 4 + t) * 512 + tid] = vnr[t]; }
    const float* Wg = INL(26, 4 * 128 * 128) + (size_t)g * 128 * 128; const float* bs = INL(27, 512) + g * 128;
#pragma unroll
    for (int t = 0; t < 4; ++t) { float mx = bs[t];
#pragma unroll
        for (int s = 0; s < 4; ++s) if (s <= t) mx += Wg[t * 128 + s] * vnr[s];
        const float u = gelu_erf(P[(size_t)(r0 + t) * LDP + SG_U + tid]);
        MIX[(size_t)(r0 + t) * DM + 1536 + tid] = (bf16_t)f2bf(u * mx); }
    __syncthreads();
}

__device__ __forceinline__ void phase_c2(const Args& A, int l, LAS unsigned char* lds) {
    const int G = gridDim.x, blk = blockIdx.x;
    constexpr int N_RP = 128, N_MP = 32, N_LONG = N_RP + N_MP;
    constexpr int N_SGP = 256, N_SGS = 128, N_MS = 512, N_RS = 1024, N_OTHER = N_SGP + N_SGS + N_MS + N_RS;
    { int it = blk;
      for (; it < N_RP; it += G) rwkv_prompt(A, l, lds, it);
      for (; it < N_LONG; it += G) mlstm_prompt(A, l, lds, (it - N_RP) >> 1, (it - N_RP) & 1); }
    unsigned* qctr = (unsigned*)(A.ws + WS_CTL + 768 * 1024) + l * 64;
    volatile LAS unsigned* tick = (volatile LAS unsigned*)(lds + 131072 + 64 + 32);
    for (;;) {
        __syncthreads();
        if (threadIdx.x == 0) tick[0] = __hip_atomic_fetch_add(qctr, 1u, __ATOMIC_RELAXED, __HIP_MEMORY_SCOPE_AGENT);
        __syncthreads();
        const int it = (int)tick[0];
        if (it >= N_OTHER) break;
        if (it < N_SGP) sgu_prompt(A, l, lds, it);
        else if (it < N_SGP + N_MS) mlstm_sample(A, l, lds, it - N_SGP);
        else if (it < N_SGP + N_MS + N_RS) rwkv_sample2(A, l, lds, it - N_SGP - N_MS);
        else sgu_sample(A, l, lds, it - N_SGP - N_MS - N_RS);
    }
}

__device__ __forceinline__ void phase_c3(const Args& A, int l) {
    int tid = threadIdx.x; asm volatile("" : "+v"(tid)); const int lane = tid & 63, wave = tid >> 6, G = gridDim.x;
    const float* P = WSP(float, WS_P); const float* HM = WSP(float, WS_HM); const float* Y = WSP(float, WS_Y); const float* AAp = WSP(float, WS_AA); const bf16_t* GG = WSP(bf16_t, WS_GG);
    bf16_t* MIX = WSP(bf16_t, WS_MIX);
    const float* mu = INL(13, RWC);
    for (int it = blockIdx.x * 8 + wave; it < TT * 5; it += G * 8) {
        const int row = it / 5, part = it - row * 5;
        const float* prow = P + (size_t)row * LDP;
        if (part == 4) {
            const int c = lane * 8;
            const f32x4 x0 = *(const f32x4*)(HM + (size_t)row * 512 + c), x1 = *(const f32x4*)(HM + (size_t)row * 512 + c + 4);
            const f32x4 o0 = *(const f32x4*)(prow + ML_O + c), o1 = *(const f32x4*)(prow + ML_O + c + 4);
            const f32x4 g0 = *(const f32x4*)(INL(12, 512) + c), g1 = *(const f32x4*)(INL(12, 512) + c + 4);
            float ss = (x0[0] * x0[0] + x0[1] * x0[1]) + (x0[2] * x0[2] + x0[3] * x0[3]) + (x1[0] * x1[0] + x1[1] * x1[1]) + (x1[2] * x1[2] + x1[3] * x1[3]);
            ss = row16_sum(ss); const float r = rsqrtf(ss * (1.0f / 128.0f) + EPS);
            u32x4 w;
            w.x = pk2(x0[0] * r * g0[0] * sigmoidf_(o0[0]), x0[1] * r * g0[1] * sigmoidf_(o0[1])); w.y = pk2(x0[2] * r * g0[2] * sigmoidf_(o0[2]), x0[3] * r * g0[3] * sigmoidf_(o0[3]));
            w.z = pk2(x1[0] * r * g1[0] * sigmoidf_(o1[0]), x1[1] * r * g1[1] * sigmoidf_(o1[1])); w.w = pk2(x1[2] * r * g1[2] * sigmoidf_(o1[2]), x1[3] * r * g1[3] * sigmoidf_(o1[3]));
            *(u32x4*)(MIX + (size_t)row * DM + c) = w;
            int shb = -1; float* dst = nullptr;
            if (row < NPR) { if ((row & (SEQ - 1)) == SEQ - 1) { shb = row >> 11; dst = A.out + O_SHP + (size_t)(l * 4 + shb) * RWC; } }
            else { const int s2 = row - NPR; if ((s2 & 3) == 3) { shb = s2 >> 2; dst = A.out + O_SHS + (size_t)(l * 128 + shb) * RWC; } }
            if (shb >= 0) for (int cc = lane * 4; cc < RWC; cc += 256) *(f32x4*)(dst + cc) = *(const f32x4*)(prow + RW0 + cc);
        } else {
            const int c = part * 256 + lane * 4;
            const f32x4 y = *(const f32x4*)(Y + (size_t)row * 1024 + c);
            const f32x4 pv = *(const f32x4*)(prow + RW_V + c);
            const f32x4 qv = ld_prev4(A, l, P, row, RW_V + c);
            const u32x2 ggb = *(const u32x2*)(GG + (size_t)row * 1024 + c);
            const float bc = WSP(float, WS_BC)[(size_t)row * 16 + (c >> 6)];
            const f32x4 m_v = *(const f32x4*)(mu + (RW_V - RW0) + c);
            const f32x4 lg = *(const f32x4*)(INL(22, 1024) + c), lb = *(const f32x4*)(INL(23, 1024) + c);
            const float mean = row16_sum((y[0] + y[1]) + (y[2] + y[3])) * (1.0f / 64.0f);
            const f32x4 d = y - mean;
            const float var = row16_sum((d[0] * d[0] + d[1] * d[1]) + (d[2] * d[2] + d[3] * d[3])) * (1.0f / 64.0f);
            const f32x4 yn = d * rsqrtf(var + 64.0f * 1e-5f) * lg + lb;
            const f32x4 v = pv + (qv - pv) * m_v;
            f32x4 gg; gg[0] = __builtin_bit_cast(float, ggb.x << 16); gg[1] = __builtin_bit_cast(float, ggb.x & 0xffff0000u); gg[2] = __builtin_bit_cast(float, ggb.y << 16); gg[3] = __builtin_bit_cast(float, ggb.y & 0xffff0000u);
            const f32x4 o = (yn + v * bc) * gg;
            u32x2 w; w.x = pk2(o[0], o[1]); w.y = pk2(o[2], o[3]);
            *(u32x2*)(MIX + (size_t)row * DM + 512 + c) = w;
        }
    }
}

__device__ __forceinline__ void ld8(const bf16_t* p, float (&o)[8]) { const u32x4 w = *(const u32x4*)p; o[0] = __builtin_bit_cast(float, w.x << 16); o[1] = __builtin_bit_cast(float, w.x & 0xffff0000u); o[2] = __builtin_bit_cast(float, w.y << 16); o[3] = __builtin_bit_cast(float, w.y & 0xffff0000u);
    o[4] = __builtin_bit_cast(float, w.z << 16); o[5] = __builtin_bit_cast(float, w.z & 0xffff0000u); o[6] = __builtin_bit_cast(float, w.w << 16); o[7] = __builtin_bit_cast(float, w.w & 0xffff0000u); }
__device__ __forceinline__ void ld8f(const float* p, float (&o)[8]) { const f32x4 a = *(const f32x4*)p, b = *(const f32x4*)(p + 4); o[0] = a[0]; o[1] = a[1]; o[2] = a[2]; o[3] = a[3]; o[4] = b[0]; o[5] = b[1]; o[6] = b[2]; o[7] = b[3]; }
__device__ __forceinline__ void st8f(float* p, const float (&o)[8]) { *(f32x4*)p = (f32x4){o[0], o[1], o[2], o[3]}; *(f32x4*)(p + 4) = (f32x4){o[4], o[5], o[6], o[7]}; }
__device__ __forceinline__ void phase_f(const Args& A, int l) {
    const int G = gridDim.x; int tid = threadIdx.x; asm volatile("" : "+v"(tid));
    const bf16_t* HUP = WSP(bf16_t, WS_HUP); bf16_t* ACT = WSP(bf16_t, WS_ACT);
    const float* cw = INL(31, 3 * DFF2); const float* cb = INL(32, DFF2);
    constexpr int NFC = DFF / 8, RSTR = 8, NSTR = TT / RSTR;
    for (int it = blockIdx.x * 512 + tid; it < NFC * NSTR; it += G * 512) {
        const int fc = it % NFC, strip = it / NFC, f = fc * 8;
        float wg[3][8], wv[3][8], bg[8], bv[8];
#pragma unroll
        for (int j = 0; j < 3; ++j) { ld8f(cw + (size_t)j * DFF2 + f, wg[j]); ld8f(cw + (size_t)j * DFF2 + DFF + f, wv[j]); }
        ld8f(cb + f, bg); ld8f(cb + DFF + f, bv);
        const int rowb = strip * RSTR;
        u32x4 cg_[RSTR], cv_[RSTR];
#pragma unroll
        for (int rr = 0; rr < RSTR; ++rr) { cg_[rr] = *(const u32x4*)(HUP + (size_t)(rowb + rr) * DFF2 + f); cv_[rr] = *(const u32x4*)(HUP + (size_t)(rowb + rr) * DFF2 + DFF + f); }
        float g0[8], g1[8], v0[8], v1[8];
        if (rowb < NPR) {
            if ((rowb & (SEQ - 1)) == 0) {
#pragma unroll
                for (int e = 0; e < 8; ++e) { g0[e] = 0.f; g1[e] = 0.f; v0[e] = 0.f; v1[e] = 0.f; } }
            else { ld8(HUP + (size_t)(rowb - 2) * DFF2 + f, g0); ld8(HUP + (size_t)(rowb - 2) * DFF2 + DFF + f, v0); ld8(HUP + (size_t)(rowb - 1) * DFF2 + f, g1); ld8(HUP + (size_t)(rowb - 1) * DFF2 + DFF + f, v1); }
        }
#pragma unroll
        for (int rr = 0; rr < RSTR; ++rr) {
            const int row = rowb + rr;
            int t, Tn, bidx; if (row < NPR) { t = row & (SEQ - 1); Tn = SEQ; bidx = row >> 11; } else { t = (row - NPR) & 3; Tn = 4; bidx = (row - NPR) >> 2; }
            if (row >= NPR && t == 0) { const float* bp = A.in[7] + ((size_t)(l * 128 + bidx) * 2) * DFF2; ld8f(bp + f, g0); ld8f(bp + DFF + f, v0); ld8f(bp + DFF2 + f, g1); ld8f(bp + DFF2 + DFF + f, v1); }
            float hg[8], hv[8];
            { const u32x4 w = cg_[rr]; hg[0] = __builtin_bit_cast(float, w.x << 16); hg[1] = __builtin_bit_cast(float, w.x & 0xffff0000u); hg[2] = __builtin_bit_cast(float, w.y << 16); hg[3] = __builtin_bit_cast(float, w.y & 0xffff0000u);
              hg[4] = __builtin_bit_cast(float, w.z << 16); hg[5] = __builtin_bit_cast(float, w.z & 0xffff0000u); hg[6] = __builtin_bit_cast(float, w.w << 16); hg[7] = __builtin_bit_cast(float, w.w & 0xffff0000u); }
            { const u32x4 w = cv_[rr]; hv[0] = __builtin_bit_cast(float, w.x << 16); hv[1] = __builtin_bit_cast(float, w.x & 0xffff0000u); hv[2] = __builtin_bit_cast(float, w.y << 16); hv[3] = __builtin_bit_cast(float, w.y & 0xffff0000u);
              hv[4] = __builtin_bit_cast(float, w.z << 16); hv[5] = __builtin_bit_cast(float, w.z & 0xffff0000u); hv[6] = __builtin_bit_cast(float, w.w << 16); hv[7] = __builtin_bit_cast(float, w.w & 0xffff0000u); }
            float o[8];
#pragma unroll
            for (int e = 0; e < 8; ++e) { const float gt = bg[e] + wg[0][e] * g0[e] + wg[1][e] * g1[e] + wg[2][e] * hg[e]; const float vl = bv[e] + wv[0][e] * v0[e] + wv[1][e] * v1[e] + wv[2][e] * hv[e];
                o[e] = gt * sigmoidf_(gt) * vl; }
            u32x4 w; w.x = pk2(o[0], o[1]); w.y = pk2(o[2], o[3]); w.z = pk2(o[4], o[5]); w.w = pk2(o[6], o[7]);
            *(u32x4*)(ACT + (size_t)row * DFF + f) = w;
            if (t >= Tn - 2) { const int jj = t - (Tn - 2);
                float* dst = (row < NPR) ? A.out + O_CBP + ((size_t)(l * 4 + bidx) * 2 + jj) * DFF2 : A.out + O_CBS + ((size_t)(l * 128 + bidx) * 2 + jj) * DFF2;
                st8f(dst + f, hg); st8f(dst + DFF + f, hv); }
#pragma unroll
            for (int e = 0; e < 8; ++e) { g0[e] = g1[e]; g1[e] = hg[e]; v0[e] = v1[e]; v1[e] = hv[e]; }
        }
    }
}

__device__ __forceinline__ void phase_r(const Args& A, int KS, float* rsn) {
    int tid = threadIdx.x; asm volatile("" : "+v"(tid)); const int lane = tid & 63, wave = tid >> 6, G = gridDim.x;
    bf16_t* XB = WSP(bf16_t, WS_XB); const float* PART = WSP(float, WS_P);
    for (int it = blockIdx.x * 8 + wave; it < NSM * 2; it += G * 8) {
        const int rl = it >> 1, hf = it & 1, row = NPR + rl; float ss = 0.f;
#pragma unroll
        for (int j = 0; j < 4; ++j) { const int c = hf * 1024 + j * 256 + lane * 4; f32x4 x = ldp4(XB + (size_t)row * DM + c);
            for (int p = 0; p < KS; ++p) x += *(const f32x4*)(PART + ((size_t)p * NSM + rl) * DM + c);
            u32x2 w; w.x = pk2(x[0], x[1]); w.y = pk2(x[2], x[3]); *(u32x2*)(XB + (size_t)row * DM + c) = w;
            ss += (x[0] * x[0] + x[1] * x[1]) + (x[2] * x[2] + x[3] * x[3]); }
        ss = wave_sum(ss);
        if (lane == 0) unsafeAtomicAdd(rsn + row, ss);
    }
}

__device__ __forceinline__ void phase_final(const Args& A) {
    int tid = threadIdx.x; asm volatile("" : "+v"(tid)); const int lane = tid & 63, wave = tid >> 6, G = gridDim.x;
    const bf16_t* XB = WSP(bf16_t, WS_XB); const float* RS = WSP(float, WS_CTL) + 4 * TT; const float* g = A.in[34];
    for (int row = blockIdx.x * 8 + wave; row < TT; row += G * 8) {
        const float s = rsqrtf(RS[row] * (1.0f / DM) + EPS);
#pragma unroll
        for (int j = 0; j < 8; ++j) { const int c = j * 256 + lane * 4; const f32x4 v = ldp4(XB + (size_t)row * DM + c); const f32x4 gg = *(const f32x4*)(g + c);
            *(f32x4*)(A.out + (size_t)row * DM + c) = v * s * gg; }
    }
}

#define XB_TMO      128
#define XB_XCNT(j)  (256  + 64 * (j))
#define XB_XSUB(j)  (1280 + 64 * (j))
#define XB_XGEN(j)  (2304 + 64 * (j))
#define XB_TOP      3328
#define XB_TOPGEN   3392
#define XCD_BAR_WORDS 3456
#define XB_SPIN_CAP (1u << 18)

__device__ __forceinline__ unsigned xb_ld(unsigned* p)              { return __hip_atomic_load(p, __ATOMIC_RELAXED, __HIP_MEMORY_SCOPE_AGENT); }
__device__ __forceinline__ unsigned xb_add(unsigned* p, unsigned v) { return __hip_atomic_fetch_add(p, v, __ATOMIC_RELAXED, __HIP_MEMORY_SCOPE_AGENT); }
__device__ __forceinline__ unsigned xb_xcc_id() { return (unsigned)__builtin_amdgcn_s_getreg((3 << 11) | 20) & 0xFu; }
#define XB_SPIN(cond, bar) do { unsigned _sp = 0; while (cond) { __builtin_amdgcn_s_sleep(1); \
    if ((++_sp & 255u) == 0u) { if (xb_ld(&(bar)[XB_TMO])) break; if (_sp > XB_SPIN_CAP) { atomicAdd(&(bar)[XB_TMO], 1u); break; } } } } while (0)

struct XcdBarrier {
    unsigned* bar; unsigned x;
    volatile LAS unsigned* st;
};

__device__ __forceinline__ XcdBarrier xcd_barrier_post(unsigned* bar, volatile LAS unsigned* st) {
    XcdBarrier b; b.bar = bar; b.x = xb_xcc_id(); b.st = st;
    if (threadIdx.x == 0) (void)xb_add(&bar[XB_XCNT(b.x)], 1u);
    return b;
}
__device__ __forceinline__ void xcd_barrier_complete(unsigned* bar, unsigned x, unsigned& nloc, unsigned& nx) {
    const unsigned G = gridDim.x * gridDim.y * gridDim.z;
    unsigned sum, cnt, mine, sp = 0u;
    for (;;) {
        sum = 0u; cnt = 0u; mine = 0u;
#pragma unroll
        for (unsigned j = 0; j < 16; ++j) { const unsigned c = xb_ld(&bar[XB_XCNT(j)]); sum += c; cnt += (c > 0u) ? 1u : 0u; mine = (j == x) ? c : mine; }
        if (sum == G) break;
        __builtin_amdgcn_s_sleep(1);
        if ((++sp & 255u) == 0u) { if (xb_ld(&bar[XB_TMO])) break; if (sp > XB_SPIN_CAP) { atomicAdd(&bar[XB_TMO], 1u); break; } }
    }
    nloc = mine > 0u ? mine : 1u; nx = cnt > 0u ? cnt : 1u;
}

__device__ __forceinline__ void xcd_barrier(const XcdBarrier& b) {
    asm volatile("s_waitcnt vmcnt(0)" ::: "memory");
    __syncthreads();
    if (threadIdx.x == 0) {
        unsigned* bar = b.bar;
        __builtin_amdgcn_s_waitcnt(0);
        unsigned nloc = b.st[0], nx = b.st[1];
        if (nloc == 0u) { xcd_barrier_complete(bar, b.x, nloc, nx); b.st[0] = nloc; b.st[1] = nx; }
        const unsigned old = xb_add(&bar[XB_XSUB(b.x)], 1u);
        const unsigned gen = old / nloc;
        if (old + 1u == (gen + 1u) * nloc) {
            __builtin_amdgcn_fence(__ATOMIC_RELEASE, "agent");
            asm volatile("s_waitcnt vmcnt(0)" ::: "memory");
            const unsigned og = xb_add(&bar[XB_TOP], 1u);
            const unsigned tg = og / nx;
            if (og + 1u == (tg + 1u) * nx) xb_add(&bar[XB_TOPGEN], 1u);
            else XB_SPIN(xb_ld(&bar[XB_TOPGEN]) == tg, bar);
            __builtin_amdgcn_fence(__ATOMIC_ACQUIRE, "agent");
            xb_add(&bar[XB_XGEN(b.x)], 1u);
            asm volatile("s_waitcnt vmcnt(0)" ::: "memory");
        } else {
            XB_SPIN(xb_ld(&bar[XB_XGEN(b.x)]) == gen, bar);
            __builtin_amdgcn_fence(__ATOMIC_ACQUIRE, "agent");
            asm volatile("s_waitcnt vmcnt(0)" ::: "memory");
        }
    }
    __syncthreads();
}

constexpr int N_SUB = 10, N_PHASES = 2 + 2 * N_SUB;
constexpr int KS_D = 8, KS_G = 11;
__global__ void __launch_bounds__(512, 2) fwd(Args A0) {
    extern __shared__ __attribute__((aligned(16))) unsigned char lds_raw[];
    LAS unsigned char* lds = (LAS unsigned char*)lds_raw;
    cg::grid_group grid = cg::this_grid();
    const int G = gridDim.x;
    volatile LAS unsigned* MISC = (volatile LAS unsigned*)(lds + 131072 + 64);
    if (threadIdx.x < 4) MISC[threadIdx.x] = 0u;
    __syncthreads();
    XcdBarrier xbar = xcd_barrier_post((unsigned*)(A0.ws + WS_CTL + 512 * 1024), MISC);
    bool first_seam = true;
    for (int ph = A0.ph_lo; ph < A0.ph_hi; ++ph) {
        const int l = (ph - 1) / N_SUB, sub = (ph - 1) % N_SUB;
        const int dupbit = (ph == 0) ? 0 : (ph == N_PHASES - 1) ? 1 : 2 + sub;
        const int reps = 1 + ((DUP_MASK >> dupbit) & 1);
        for (int rep = 0; rep < reps; ++rep) {
        if (ph > A0.ph_lo || rep > 0) { if (first_seam) { grid.sync(); first_seam = false; } else xcd_barrier(xbar); }
        Args B = A0; { size_t z = 0; asm volatile("s_mov_b64 %0, 0" : "=s"(z)); B.ws = A0.ws + z; B.out = A0.out + z; } const Args& A = B;
        if (ph == 0) { phase_prologue(A, lds); continue; }
        if (ph == N_PHASES - 1) { phase_final(A); continue; }
        float* RS = WSP(float, WS_CTL);
        switch (sub) {
        case 0: { pg8::Gemm g{WSP(bf16_t, WS_XB), WSP(bf16_t, WS_WIN) + (size_t)l * LDP * DM, TT, LDP, DM, DM, DM}; pg8::StaticOrder S; S.init(TT, LDP, G, (int)blockIdx.x);
                  pg8::EpiP E{WSP(float, WS_P), LDP, RS + (size_t)(2 * l) * TT}; pg8::gemm_phase<pg8::EpiP, pg8::StaticOrder>(lds, g, S, E); } break;
        case 1: phase_c1(A, l, lds); break;
        case 2: phase_c2(A, l, lds); break;
        case 3: phase_c3(A, l); break;
        case 4: { { pg8::Gemm g{WSP(bf16_t, WS_MIX), WSP(bf16_t, WS_WOUT) + (size_t)l * DM * DM, NPR, DM, DM, DM, DM}; pg8::StaticOrder S; S.init(NPR, DM, G, (int)blockIdx.x);
                    pg8::EpiRes E{WSP(bf16_t, WS_XB), RS + (size_t)(2 * l + 1) * TT}; pg8::gemm_phase<pg8::EpiRes, pg8::StaticOrder>(lds, g, S, E); }
                  { pg8::Gemm g{WSP(bf16_t, WS_MIX) + (size_t)NPR * DM, WSP(bf16_t, WS_WOUT) + (size_t)l * DM * DM, NSM, DM, DM / KS_D, DM, DM}; pg8::SplitOrder S; S.init(NSM, DM, KS_D, G, (int)((blockIdx.x + 128) % G));
                    pg8::EpiPart E{WSP(float, WS_P), NSM}; pg8::gemm_phase<pg8::EpiPart, pg8::SplitOrder>(lds, g, S, E); } } break;
        case 5: phase_r(A, KS_D, RS + (size_t)(2 * l + 1) * TT); break;
        case 6: { pg8::Gemm g{WSP(bf16_t, WS_XB), WSP(bf16_t, WS_WUP) + (size_t)l * DFF2 * DM, TT, DFF2, DM, DM, DM}; pg8::StaticOrder S; S.init(TT, DFF2, G, (int)blockIdx.x);
                  pg8::EpiUp E{WSP(bf16_t, WS_HUP), DFF2, RS + (size_t)(2 * l + 1) * TT}; pg8::gemm_phase<pg8::EpiUp, pg8::StaticOrder>(lds, g, S, E); } break;
        case 7: phase_f(A, l); break;
        case 8: { { pg8::Gemm g{WSP(bf16_t, WS_ACT), WSP(bf16_t, WS_WDN) + (size_t)l * DM * DFF, NPR, DM, DFF, DFF, DFF}; pg8::StaticOrder S; S.init(NPR, DM, G, (int)blockIdx.x);
                    pg8::EpiRes E{WSP(bf16_t, WS_XB), RS + (size_t)(2 * l + 2) * TT}; pg8::gemm_phase<pg8::EpiRes, pg8::StaticOrder>(lds, g, S, E); }
                  { pg8::Gemm g{WSP(bf16_t, WS_ACT) + (size_t)NPR * DFF, WSP(bf16_t, WS_WDN) + (size_t)l * DM * DFF, NSM, DM, DFF / KS_G, DFF, DFF}; pg8::SplitOrder S; S.init(NSM, DM, KS_G, G, (int)((blockIdx.x + 128) % G));
                    pg8::EpiPart E{WSP(float, WS_P), NSM}; pg8::gemm_phase<pg8::EpiPart, pg8::SplitOrder>(lds, g, S, E); } } break;
        case 9: phase_r(A, KS_G, RS + (size_t)(2 * l + 2) * TT); break;
        }
        }
    }
}

extern "C" void kernel_launch(void* const* d_in, const int* in_sizes, int n_in, void* d_out, int out_size, void* d_ws, size_t ws_size, hipStream_t stream) {
    static int grid = 0;
    if (grid == 0) {
        if (n_in != 35 || (size_t)out_size != O_END || ws_size < WS_END) { fprintf(stderr, "kernel_launch: unexpected sizes n_in %d out %d ws %zu (need %zu)\n", n_in, out_size, ws_size, (size_t)WS_END); grid = -1; return; }
        if (hipFuncSetAttribute((const void*)fwd, hipFuncAttributeMaxDynamicSharedMemorySize, LDS_BYTES) != hipSuccess) { fprintf(stderr, "kernel_launch: hipFuncSetAttribute failed\n"); grid = -1; return; }
        int dev = 0, cus = 0, per_cu = 0;
        hipGetDevice(&dev); hipDeviceGetAttribute(&cus, hipDeviceAttributeMultiprocessorCount, dev);
        if (hipOccupancyMaxActiveBlocksPerMultiprocessor(&per_cu, (const void*)fwd, 512, LDS_BYTES) != hipSuccess || per_cu < 1) { fprintf(stderr, "kernel_launch: occupancy query failed (%d)\n", per_cu); per_cu = 1; }
        (void)hipGetLastError();
        grid = cus * per_cu;
        fprintf(stderr, "kernel_launch: grid %d (cus %d x %d)\n", grid, cus, per_cu);
    }
    if (grid < 0) return;
    (void)hipMemsetAsync((char*)d_ws + WS_CTL, 0, CTL_BYTES, stream);
    Args a{};
    for (int i = 0; i < 35; ++i) a.in[i] = (const float*)d_in[i];
    a.out = (float*)d_out; a.ws = (unsigned char*)d_ws;
#if MK_ONE_LAUNCH
    a.ph_lo = 0; a.ph_hi = N_PHASES;
    void* args[] = {&a};
    hipError_t e = hipLaunchCooperativeKernel((const void*)fwd, dim3(grid), dim3(512), args, LDS_BYTES, stream);
    if (e != hipSuccess) fprintf(stderr, "kernel_launch: cooperative launch failed: %s (grid %d)\n", hipGetErrorString(e), grid);
#else
    for (int ph = 0; ph < N_PHASES; ++ph) { a.ph_lo = ph; a.ph_hi = ph + 1; hipLaunchKernelGGL(fwd, dim3(grid), dim3(512), LDS_BYTES, stream, a); }
#endif
}
```
